# Optimizing an MI355X kernel written in HIP

```python
import jax, jax.numpy as jnp
from jax import lax
import numpy as np

D_MODEL = 1024
BATCH = 8
SEQ = 4096
DEPTH = 4
DEC_BATCH = 16
DEC_SEQ = 2048
PAST_LEN = 128

GRID_W = 64
MEM_LEN = 256
N_GROUPS = 4
BRANCH_W = D_MODEL // N_GROUPS
N_HEADS = 4
HEAD_DIM = BRANCH_W // N_HEADS
ATT_KV_HEADS = 2
ROPE_AXIS_DIM = HEAD_DIM // 2
ROPE_THETA = 10000.0
Q_BLOCK = 128
CHUNK = 64
CONV_K = 3
N_DIRS = 2
GLA_DK = HEAD_DIM // 2
GLA_RANK = 16
GLA_NORMALIZER = 16.0
EPS = 1e-6

SPLITS = (
    N_HEADS * HEAD_DIM,
    ATT_KV_HEADS * HEAD_DIM,
    ATT_KV_HEADS * HEAD_DIM,
    BRANCH_W,
    3 * N_HEADS * HEAD_DIM,
    N_DIRS * N_HEADS,
    N_DIRS * N_HEADS,
    BRANCH_W,
    N_HEADS * GLA_DK,
    N_HEADS * GLA_DK,
    N_HEADS * HEAD_DIM,
    N_DIRS * GLA_RANK,
    BRANCH_W,
    N_HEADS * HEAD_DIM,
    BRANCH_W,
)
IN_COLS = sum(SPLITS)

kernel_name = 'hybrid_parallel_head_encoder'


def rms_norm(x, g):
    xf = x.astype(jnp.float32)
    y = xf * lax.rsqrt(jnp.mean(xf * xf, axis=-1, keepdims=True) + EPS)
    return (y * g.astype(jnp.float32)).astype(x.dtype)


def l2_norm(x):
    xf = x.astype(jnp.float32)
    return (xf * lax.rsqrt(jnp.sum(xf * xf, axis=-1, keepdims=True) + EPS)).astype(x.dtype)


def axial_rope_tables(n_tokens):
    rows = n_tokens // GRID_W
    row_pos = jnp.repeat(jnp.arange(rows, dtype=jnp.float32), GRID_W)
    col_pos = jnp.tile(jnp.arange(GRID_W, dtype=jnp.float32), rows)
    inv_freq = ROPE_THETA ** (-jnp.arange(0, ROPE_AXIS_DIM, 2, dtype=jnp.float32) / ROPE_AXIS_DIM)
    ang = jnp.stack([row_pos, col_pos], axis=-1)[..., None] * inv_freq
    return jnp.cos(ang), jnp.sin(ang)


def apply_axial_rope(x, cos, sin):
    B, S, H, D = x.shape
    half = ROPE_AXIS_DIM // 2
    xf = x.astype(jnp.float32).reshape(B, S, H, 2, 2, half)
    x1, x2 = xf[..., 0, :], xf[..., 1, :]
    c, s = cos[:, None], sin[:, None]
    out = jnp.stack([x1 * c - x2 * s, x2 * c + x1 * s], axis=-2)
    return out.reshape(B, S, H, D).astype(x.dtype)


def block_attention(q, k, v):
    B, S, H, D = q.shape
    kvh = k.shape[2]
    nb = S // Q_BLOCK
    qb = q.reshape(B, nb, Q_BLOCK, kvh, H // kvh, D).transpose(1, 0, 2, 3, 4, 5)
    scale = D ** -0.5

    def one_block(qblk):
        s = jnp.einsum('bqkgd,blkd->bkgql', qblk, k).astype(jnp.float32) * scale
        p = jax.nn.softmax(s, axis=-1).astype(v.dtype)
        return jnp.einsum('bkgql,blkd->bqkgd', p, v)

    o = lax.map(one_block, qb)
    return o.transpose(1, 0, 2, 3, 4, 5).reshape(B, S, H * D)


def short_conv_centered(x, w):
    S = x.shape[1]
    pad = CONV_K // 2
    xp = jnp.pad(x, ((0, 0), (pad, pad), (0, 0)))
    out = xp[:, 0:S] * w[0]
    for i in range(1, CONV_K):
        out = out + xp[:, i:i + S] * w[i]
    return out


def _to_chunks(x):
    B, S, H = x.shape[:3]
    x = x.reshape(B, S // CHUNK, CHUNK, H, *x.shape[3:])
    return jnp.moveaxis(x, 3, 1)


def _from_chunks(x):
    x = jnp.moveaxis(x, 1, 3)
    B, N, C, H = x.shape[:4]
    return x.reshape(B, N * C, H, *x.shape[4:])


def gated_delta_rule(q, k, v, beta, g):
    out_dtype = v.dtype
    q, k, v, beta, g = [_to_chunks(t.astype(jnp.float32)) for t in (q, k, v, beta, g)]
    dk, dv = q.shape[-1], v.shape[-1]
    q = q * dk ** -0.5
    b = jnp.cumsum(g, axis=-1)
    incl = jnp.tril(jnp.ones((CHUNK, CHUNK), bool))
    strict = jnp.tril(jnp.ones((CHUNK, CHUNK), bool), -1)
    diff = b[..., :, None] - b[..., None, :]
    decay = jnp.where(incl, jnp.exp(jnp.where(incl, diff, 0.0)), 0.0)
    kk = jnp.einsum('bhnid,bhnjd->bhnij', k, k)
    lower = jnp.where(strict, beta[..., :, None] * kk * decay, 0.0)
    t_mat = lower + jnp.eye(CHUNK, dtype=jnp.float32)
    rhs = jnp.concatenate([v * beta[..., None], k * (beta * jnp.exp(b))[..., None]], axis=-1)
    sol = lax.linalg.triangular_solve(t_mat, rhs, left_side=True, lower=True)
    u, w = sol[..., :dv], sol[..., dv:]
    qk = jnp.einsum('bhnid,bhnjd->bhnij', q, k) * decay
    q_dec = q * jnp.exp(b)[..., None]
    b_last = b[..., -1:]
    k_dec = k * jnp.exp(b_last - b)[..., None]
    chunk_decay = jnp.exp(b_last[..., 0])
    xs = tuple(jnp.moveaxis(t, 2, 0) for t in (q_dec, qk, u, w, k_dec, chunk_decay))

    def step(state, inp):
        qd, a, u_c, w_c, kd, cd = inp
        v_new = u_c - jnp.einsum('bhcd,bhde->bhce', w_c, state)
        o = jnp.einsum('bhcd,bhde->bhce', qd, state) + jnp.einsum('bhij,bhje->bhie', a, v_new)
        state = cd[..., None, None] * state + jnp.einsum('bhcd,bhce->bhde', kd, v_new)
        return state, o

    B, H = q.shape[:2]
    s0 = jnp.zeros((B, H, dk, dv), jnp.float32)
    _, o = lax.scan(step, s0, xs)
    return _from_chunks(jnp.moveaxis(o, 0, 2)).astype(out_dtype)


def gla_chunked(q, k, v, gk):
    out_dtype = v.dtype
    q, k, v, gk = [_to_chunks(t.astype(jnp.float32)) for t in (q, k, v, gk)]
    dk, dv = q.shape[-1], v.shape[-1]
    q = q * dk ** -0.5
    b = jnp.cumsum(gk, axis=3)
    q_e = q * jnp.exp(b)
    k_e = k * jnp.exp(-b)
    incl = jnp.tril(jnp.ones((CHUNK, CHUNK), bool))
    attn = jnp.where(incl, jnp.einsum('bhnid,bhnjd->bhnij', q_e, k_e), 0.0)
    o = jnp.einsum('bhnij,bhnje->bhnie', attn, v)
    b_last = b[..., -1:, :]
    k_dec = k * jnp.exp(b_last - b)
    d_state = jnp.einsum('bhncd,bhnce->bhnde', k_dec, v)
    chunk_decay = jnp.exp(b_last[..., 0, :])

    def step(state, inp):
        ds, cd = inp
        return cd[..., None] * state + ds, state

    B, H = q.shape[:2]
    s0 = jnp.zeros((B, H, dk, dv), jnp.float32)
    _, starts = lax.scan(step, s0, (jnp.moveaxis(d_state, 2, 0), jnp.moveaxis(chunk_decay, 2, 0)))
    o = o + jnp.einsum('bhncd,nbhde->bhnce', q_e, starts)
    return _from_chunks(o).astype(out_dtype)


def encoder_layer(h, mem, cos, sin, norm_g, w_in, att_q_norm_g, att_k_norm_g, gdn_conv_w, gdn_a_log,
                  gdn_dt_bias, gdn_out_norm_g, gla_w_gate_up, gla_b_gate, gla_out_norm_g, mem_norm_g,
                  w_mem_kv, w_out):
    B, S, _ = h.shape
    f32 = jnp.float32
    rev = lambda t: jnp.flip(t, axis=1)
    heads = lambda t, d: t.reshape(B, S, -1, d)

    xn = rms_norm(h, norm_g)
    proj = jnp.einsum('bsd,de->bse', xn, w_in)
    offsets = np.cumsum(SPLITS)[:-1].tolist()
    (a_q, a_k, a_v, a_gate, d_qkv, d_beta, d_alpha, d_gate,
     l_q, l_k, l_v, l_low, l_gate, m_q, m_gate) = jnp.split(proj, offsets, axis=-1)

    qa = apply_axial_rope(rms_norm(heads(a_q, HEAD_DIM), att_q_norm_g), cos, sin)
    ka = apply_axial_rope(rms_norm(heads(a_k, HEAD_DIM), att_k_norm_g), cos, sin)
    ya = block_attention(qa, ka, heads(a_v, HEAD_DIM)) * jax.nn.silu(a_gate)

    qkv = jax.nn.silu(short_conv_centered(d_qkv, gdn_conv_w))
    qb, kb, vb = jnp.split(qkv, 3, axis=-1)
    qb, kb, vb = l2_norm(heads(qb, HEAD_DIM)), l2_norm(heads(kb, HEAD_DIM)), heads(vb, HEAD_DIM)
    beta = jax.nn.sigmoid(d_beta.astype(f32)).reshape(B, S, N_DIRS, N_HEADS)
    alpha = -jnp.exp(gdn_a_log.astype(f32)) * jax.nn.softplus(
        d_alpha.astype(f32).reshape(B, S, N_DIRS, N_HEADS) + gdn_dt_bias.astype(f32))
    ob = gated_delta_rule(qb, kb, vb, beta[:, :, 0], alpha[:, :, 0]) + rev(
        gated_delta_rule(rev(qb), rev(kb), rev(vb), rev(beta[:, :, 1]), rev(alpha[:, :, 1])))
    yb = (rms_norm(ob, gdn_out_norm_g) * jax.nn.silu(heads(d_gate, HEAD_DIM))).reshape(B, S, BRANCH_W)

    gate_logit = jnp.einsum('bsnr,nrk->bsnk', l_low.reshape(B, S, N_DIRS, GLA_RANK), gla_w_gate_up) + gla_b_gate
    gk = (jax.nn.log_sigmoid(gate_logit.astype(f32)) / GLA_NORMALIZER).reshape(B, S, N_DIRS, N_HEADS, GLA_DK)
    qc, kc, vc = heads(l_q, GLA_DK), heads(l_k, GLA_DK), heads(l_v, HEAD_DIM)
    oc = gla_chunked(qc, kc, vc, gk[:, :, 0]) + rev(gla_chunked(rev(qc), rev(kc), rev(vc), rev(gk[:, :, 1])))
    yc = (rms_norm(oc, gla_out_norm_g) * jax.nn.silu(heads(l_gate, HEAD_DIM))).reshape(B, S, BRANCH_W)

    n_mem = mem.shape[1]
    kv = jnp.einsum('bmd,de->bme', rms_norm(mem, mem_norm_g), w_mem_kv)
    km, vm = jnp.split(kv, 2, axis=-1)
    km = km.reshape(B, n_mem, N_HEADS, HEAD_DIM)
    vm = vm.reshape(B, n_mem, N_HEADS, HEAD_DIM)
    ym = block_attention(heads(m_q, HEAD_DIM), km, vm) * jax.nn.silu(m_gate)

    y = jnp.einsum('bse,ed->bsd', jnp.concatenate([ya, yb, yc, ym], axis=-1), w_out)
    return h + y


def encoder_trunk(x, mem, weights, final_norm_g):
    cos, sin = axial_rope_tables(x.shape[1])
    h = x
    for d in range(DEPTH):
        h = encoder_layer(h, mem, cos, sin, *[w[d] for w in weights])
    return rms_norm(h, final_norm_g)


def setup_inputs(seed: int = 0) -> dict:
    key = jax.random.key(seed)
    ks = jax.random.split(key, 24)
    nrm = jax.random.normal
    f32 = jnp.float32
    dt = jnp.exp(jax.random.uniform(ks[10], (DEPTH, N_DIRS, N_HEADS), f32, np.log(1e-3), np.log(1e-1)))
    return {
        'x_prompt': nrm(ks[0], (BATCH, SEQ, D_MODEL), f32),
        'x_sample': nrm(ks[1], (DEC_BATCH, DEC_SEQ, D_MODEL), f32),
        'mem_prompt': nrm(ks[2], (BATCH, MEM_LEN, D_MODEL), f32),
        'mem_sample': nrm(ks[3], (DEC_BATCH, MEM_LEN, D_MODEL), f32),
        'norm_g': 1.0 + 0.02 * nrm(ks[4], (DEPTH, D_MODEL), f32),
        'w_in': nrm(ks[5], (DEPTH, D_MODEL, IN_COLS), f32) * D_MODEL ** -0.5,
        'att_q_norm_g': 1.0 + 0.02 * nrm(ks[6], (DEPTH, HEAD_DIM), f32),
        'att_k_norm_g': 1.0 + 0.02 * nrm(ks[7], (DEPTH, HEAD_DIM), f32),
        'gdn_conv_w': nrm(ks[8], (DEPTH, CONV_K, 3 * N_HEADS * HEAD_DIM), f32) * CONV_K ** -0.5,
        'gdn_a_log': jnp.log(jax.random.uniform(ks[9], (DEPTH, N_DIRS, N_HEADS), f32, 1.0, 16.0)),
        'gdn_dt_bias': dt + jnp.log(-jnp.expm1(-dt)),
        'gdn_out_norm_g': 1.0 + 0.02 * nrm(ks[11], (DEPTH, HEAD_DIM), f32),
        'gla_w_gate_up': nrm(ks[12], (DEPTH, N_DIRS, GLA_RANK, N_HEADS * GLA_DK), f32) * GLA_RANK ** -0.5,
        'gla_b_gate': 0.1 * nrm(ks[13], (DEPTH, N_DIRS, N_HEADS * GLA_DK), f32),
        'gla_out_norm_g': 1.0 + 0.02 * nrm(ks[14], (DEPTH, HEAD_DIM), f32),
        'mem_norm_g': 1.0 + 0.02 * nrm(ks[15], (DEPTH, D_MODEL), f32),
        'w_mem_kv': nrm(ks[16], (DEPTH, D_MODEL, 2 * N_HEADS * HEAD_DIM), f32) * D_MODEL ** -0.5,
        'w_out': nrm(ks[17], (DEPTH, N_GROUPS * BRANCH_W, D_MODEL), f32) * (N_GROUPS * BRANCH_W) ** -0.5 * (2 * DEPTH) ** -0.5,
        'final_norm_g': 1.0 + 0.02 * nrm(ks[18], (D_MODEL,), f32),
    }


def reference(x_prompt, x_sample, mem_prompt, mem_sample, norm_g, w_in, att_q_norm_g, att_k_norm_g,
              gdn_conv_w, gdn_a_log, gdn_dt_bias, gdn_out_norm_g, gla_w_gate_up, gla_b_gate,
              gla_out_norm_g, mem_norm_g, w_mem_kv, w_out, final_norm_g):
    weights = (norm_g, w_in, att_q_norm_g, att_k_norm_g, gdn_conv_w, gdn_a_log, gdn_dt_bias,
               gdn_out_norm_g, gla_w_gate_up, gla_b_gate, gla_out_norm_g, mem_norm_g, w_mem_kv, w_out)
    y_prompt = encoder_trunk(x_prompt, mem_prompt, weights, final_norm_g)
    y_sample = encoder_trunk(x_sample, mem_sample, weights, final_norm_g)
    return (y_prompt, y_sample)
```

```cpp
#include <hip/hip_runtime.h>
#include <hip/hip_cooperative_groups.h>
#include <stdint.h>
#include <stdio.h>
namespace cg = cooperative_groups;

typedef __attribute__((ext_vector_type(8))) short bf16x8;
typedef __attribute__((ext_vector_type(4))) float f32x4;
typedef unsigned short u16;
typedef __attribute__((ext_vector_type(4))) unsigned int u32x4;
typedef __attribute__((ext_vector_type(2))) unsigned int u32x2;

#define DI __device__ __forceinline__
#define T_TOK 65536
#define DM 1024
#define NPAD 3200
#define NIN 3120
#define EPSF 1e-6f
#define LDS_STRIDE 72

static constexpr size_t SZ_C = (size_t)T_TOK * 256 * 2;
static constexpr size_t OFF_C0 = 0;
static constexpr size_t OFF_C1 = OFF_C0 + SZ_C;
static constexpr size_t OFF_C2 = OFF_C1 + SZ_C;
static constexpr size_t OFF_C3 = OFF_C2 + SZ_C;
static constexpr size_t OFF_AK = OFF_C3 + SZ_C;
static constexpr size_t OFF_AVT = OFF_AK + SZ_C / 2;
static constexpr size_t OFF_AGATE = OFF_AVT + SZ_C / 2;
static constexpr size_t OFF_DGATE = OFF_AGATE + SZ_C;
static constexpr size_t OFF_LGATE = OFF_DGATE + SZ_C;
static constexpr size_t OFF_MGATE = OFF_LGATE + SZ_C;
static constexpr size_t OFF_DQKV = OFF_MGATE + SZ_C;
static constexpr size_t OFF_LQ = OFF_DQKV + 3 * SZ_C;
static constexpr size_t OFF_LK = OFF_LQ + SZ_C / 2;
static constexpr size_t OFF_LV = OFF_LK + SZ_C / 2;
static constexpr size_t OFF_HFINAL = OFF_AK;
static constexpr size_t OFF_SMALL = OFF_LV + SZ_C;
static constexpr size_t OFF_SUMSQ = OFF_SMALL + (size_t)T_TOK * 48 * 4;
static constexpr size_t OFF_WIN = OFF_SUMSQ + (size_t)T_TOK * 16 * 4;
static constexpr size_t OFF_WOUT = OFF_WIN + (size_t)4 * NPAD * 1024 * 2;
static constexpr size_t OFF_WMKV = OFF_WOUT + (size_t)4 * 1024 * 1024 * 2;
static constexpr size_t OFF_KM = OFF_WMKV + (size_t)4 * 512 * 1024 * 2;
static constexpr size_t OFF_VMT = OFF_KM + (size_t)6144 * 256 * 2;
static constexpr size_t OFF_MEMRSTD = OFF_VMT + (size_t)6144 * 256 * 2;
static constexpr size_t OFF_ROPE = OFF_MEMRSTD + 6144 * 4;
static constexpr size_t OFF_HALO = OFF_ROPE + 2 * 64 * 16 * 4;
static constexpr size_t OFF_CNT = OFF_HALO + (size_t)512 * 2 * 768 * 2;
static constexpr size_t OFF_CUFLAG = OFF_CNT + 256;
static constexpr size_t OFF_XBAR = OFF_CUFLAG + 4 * 4096 * 4;
static constexpr size_t WS_NEED = OFF_XBAR + 3456 * 4;
static_assert(OFF_HFINAL + (size_t)T_TOK * 1024 * 4 <= OFF_SMALL, "hfinal alias");
static_assert(WS_NEED <= (size_t)536870912, "ws budget");

struct Params {
  const float* x_prompt; const float* x_sample; const float* mem_prompt; const float* mem_sample;
  const float* norm_g; const float* w_in; const float* att_q_norm_g; const float* att_k_norm_g;
  const float* gdn_conv_w; const float* gdn_a_log; const float* gdn_dt_bias; const float* gdn_out_norm_g;
  const float* gla_w_gate_up; const float* gla_b_gate; const float* gla_out_norm_g; const float* mem_norm_g;
  const float* w_mem_kv; const float* w_out; const float* final_norm_g;
  float* out; unsigned char* ws;
};

DI u16 f2bf(float f) { uint32_t u = __float_as_uint(f); u += 0x7fffu + ((u >> 16) & 1u); return (u16)(u >> 16); }
DI float bf2f(u16 h) { return __uint_as_float(((uint32_t)h) << 16); }
typedef __attribute__((ext_vector_type(2))) float f32x2_t;
typedef __attribute__((ext_vector_type(2))) __bf16 bf16x2_t;
DI uint32_t pack2(float a, float b) { f32x2_t v = {a, b}; return __builtin_bit_cast(uint32_t, __builtin_convertvector(v, bf16x2_t)); }
DI float fast_exp2(float x) { float r; asm("v_exp_f32 %0, %1\n\ts_nop 1" : "=v"(r) : "v"(x)); return r; }
DI float fast_log2(float x) { float r; asm("v_log_f32 %0, %1\n\ts_nop 1" : "=v"(r) : "v"(x)); return r; }
DI float fexp(float x) { return fast_exp2(x * 1.4426950408889634f); }
DI float flog(float x) { return fast_log2(x) * 0.6931471805599453f; }
DI float siluf(float x) { return x / (1.f + fexp(-x)); }
DI float wave_sum(float v) {
#pragma unroll
  for (int o = 32; o >= 1; o >>= 1) v += __shfl_xor(v, o);
  return v;
}
DI int seq_of_token(int t) { return t < 32768 ? (t >> 12) : 8 + ((t - 32768) >> 11); }
DI int seq_base(int s) { return s < 8 ? s * 4096 : 32768 + (s - 8) * 2048; }
DI int seq_len(int s) { return s < 8 ? 4096 : 2048; }
DI int otid() { int t = threadIdx.x; asm volatile("" : "+v"(t)); return t; }
DI f32x4 mfma16(bf16x8 a, bf16x8 b, f32x4 c) { return __builtin_amdgcn_mfma_f32_16x16x32_bf16(a, b, c, 0, 0, 0); }

DI int win_orig_col(int n) {
  if (n < 768) return n;
  if (n < 1536) return n;
  if (n < 1792) return n - 1536 + 1552;
  if (n < 1920) return n - 1792 + 1808;
  if (n < 2048) return n - 1920 + 1936;
  if (n < 2304) return n - 2048 + 2064;
  if (n < 2560) return n - 2304 + 2352;
  if (n < 2816) return n - 2560 + 2608;
  if (n < 3072) return n - 2816 + 2864;
  if (n < 3080) return n - 3072 + 1536;
  if (n < 3088) return n - 3080 + 1544;
  return n - 3088 + 2320;
}

DI void phase_prep(const Params& p, int gtid, int gthreads) {
  u16* WIN = (u16*)(p.ws + OFF_WIN);
  u16* WOUT = (u16*)(p.ws + OFF_WOUT);
  u16* WMKV = (u16*)(p.ws + OFF_WMKV);
  for (int it = gtid; it < 4 * 128 * NPAD; it += gthreads) {
    int n = it % NPAD; int r = it / NPAD; int kc = r & 127; int L = r >> 7;
    uint32_t o[4] = {0, 0, 0, 0};
    if (n < NIN) {
      int oc = win_orig_col(n);
      const float* src = p.w_in + ((size_t)L * 1024 + kc * 8) * NIN + oc;
      const float* g = p.norm_g + L * 1024 + kc * 8;
      float v[8];
#pragma unroll
      for (int j = 0; j < 8; ++j) v[j] = src[(size_t)j * NIN] * g[j];
#pragma unroll
      for (int j = 0; j < 4; ++j) o[j] = pack2(v[2 * j], v[2 * j + 1]);
    }
    *(uint4*)(WIN + ((size_t)L * NPAD + n) * 1024 + kc * 8) = make_uint4(o[0], o[1], o[2], o[3]);
  }
  for (int it = gtid; it < 4 * 128 * 1024; it += gthreads) {
    int n = it & 1023; int r = it >> 10; int kc = r & 127; int L = r >> 7;
    const float* src = p.w_out + ((size_t)L * 1024 + kc * 8) * 1024 + n;
    uint32_t o[4];
#pragma unroll
    for (int j = 0; j < 4; ++j) o[j] = pack2(src[(size_t)(2 * j) * 1024], src[(size_t)(2 * j + 1) * 1024]);
    *(uint4*)(WOUT + ((size_t)L * 1024 + n) * 1024 + kc * 8) = make_uint4(o[0], o[1], o[2], o[3]);
  }
  for (int it = gtid; it < 4 * 128 * 512; it += gthreads) {
    int n = it & 511; int r = it >> 9; int kc = r & 127; int L = r >> 7;
    const float* src = p.w_mem_kv + ((size_t)L * 1024 + kc * 8) * 512 + n;
    const float* g = p.mem_norm_g + L * 1024 + kc * 8;
    uint32_t o[4];
#pragma unroll
    for (int j = 0; j < 4; ++j) o[j] = pack2(src[(size_t)(2 * j) * 512] * g[2 * j], src[(size_t)(2 * j + 1) * 512] * g[2 * j + 1]);
    *(uint4*)(WMKV + ((size_t)L * 512 + n) * 1024 + kc * 8) = make_uint4(o[0], o[1], o[2], o[3]);
  }
  float* rope = (float*)(p.ws + OFF_ROPE);
  for (int it = gtid; it < 1024; it += gthreads) {
    int pos = it >> 4, i = it & 15;
    float inv = exp2f(-(float)i * (13.287712379549449f / 16.f));
    float a = (float)pos * inv;
    rope[it] = __cosf(a); rope[1024 + it] = __sinf(a);
  }
  int wid = gtid >> 6, nw = gthreads >> 6, lane = gtid & 63;
  u16* HI = (u16*)p.out; u16* LO = HI + (size_t)T_TOK * 1024;
  float* SUMSQ = (float*)(p.ws + OFF_SUMSQ);
  for (int t0 = wid; t0 < T_TOK; t0 += 2 * nw) {
    float4 v[2][4];
#pragma unroll
    for (int u = 0; u < 2; ++u) {
      const int t = t0 + u * nw < T_TOK ? t0 + u * nw : t0;
      const float* src = t < 32768 ? p.x_prompt + (size_t)t * 1024 : p.x_sample + (size_t)(t - 32768) * 1024;
#pragma unroll
      for (int i = 0; i < 4; ++i) v[u][i] = *(const float4*)(src + i * 256 + lane * 4);
    }
#pragma unroll
    for (int u = 0; u < 2; ++u) {
      const int t = t0 + u * nw;
      if (t < T_TOK) {
        float ss = 0.f;
#pragma unroll
        for (int i = 0; i < 4; ++i) {
          const float4 a = v[u][i];
          ss += a.x * a.x + a.y * a.y + a.z * a.z + a.w * a.w;
          *(uint2*)(HI + (size_t)t * 1024 + i * 256 + lane * 4) = make_uint2(pack2(a.x, a.y), pack2(a.z, a.w));
        }
        ss += __shfl_xor(ss, 1); ss += __shfl_xor(ss, 2);
        if ((lane & 3) == 0) SUMSQ[(size_t)t * 16 + (lane >> 2)] = ss;
      }
    }
  }
  float* MEMRSTD = (float*)(p.ws + OFF_MEMRSTD);
  for (int r = wid; r < 6144; r += nw) {
    const float* src = r < 2048 ? p.mem_prompt + (size_t)r * 1024 : p.mem_sample + (size_t)(r - 2048) * 1024;
    float ss = 0.f;
#pragma unroll
    for (int i = 0; i < 4; ++i) { float4 v = *(const float4*)(src + i * 256 + lane * 4); ss += v.x * v.x + v.y * v.y + v.z * v.z + v.w * v.w; }
    ss = wave_sum(ss);
    if (lane == 0) MEMRSTD[r] = rsqrtf(ss * (1.f / 1024.f) + EPSF);
  }
}

struct QSrc { const void* base; int ldq; const u16* c0; const u16* c1; const u16* c2; const u16* c3; };

#define QT 8
#define TM 256
template <int QMODE>
DI void gemm_load(u32x4 (&pr)[4], u32x4 (&qr)[8], const u16* W, const QSrc& q, int m0, int k0, int tid) {
  const int row0 = tid >> 3, kc = tid & 7;
  const u16* wp = W + (size_t)row0 * 1024 + k0 + kc * 8;
#pragma unroll
  for (int i = 0; i < 4; ++i) pr[i] = *(const u32x4*)(wp + (size_t)i * 32 * 1024);
  if (QMODE == 0) {
    const u16* qp = (const u16*)q.base + (size_t)(m0 + row0) * 1024 + k0 + kc * 8;
#pragma unroll
    for (int i = 0; i < 8; ++i) qr[i] = *(const u32x4*)(qp + (size_t)i * 32 * 1024);
  } else if (QMODE == 1) {
    const float* s = (const float*)q.base + (size_t)(m0 + row0) * 1024 + k0 + kc * 8;
#pragma unroll
    for (int i = 0; i < 8; ++i) {
      float4 a = *(const float4*)(s + (size_t)i * 32 * 1024), b = *(const float4*)(s + (size_t)i * 32 * 1024 + 4);
      qr[i] = (u32x4){pack2(a.x, a.y), pack2(a.z, a.w), pack2(b.x, b.y), pack2(b.z, b.w)};
    }
  } else {
    const int rg = k0 >> 8;
    const u16* cb = q.c0 + (size_t)rg * ((size_t)T_TOK * 256);
    const u16* s = cb + (size_t)(m0 + row0) * 256 + (k0 & 255) + kc * 8;
#pragma unroll
    for (int i = 0; i < 8; ++i) qr[i] = *(const u32x4*)(s + (size_t)i * 32 * 256);
  }
}

template <int QMODE>
DI void gemm_core(f32x4 (&acc)[4][QT], const u16* W  , const QSrc& q, int m0, u16* smem) {
  const int tid = otid(), lane = tid & 63, wave = tid >> 6;
  const int wn = wave & 1, wq = wave >> 1, l15 = lane & 15, quad = lane >> 4;
  u16* Ps = smem; u16* Qs = smem + 128 * LDS_STRIDE;
#pragma unroll
  for (int a = 0; a < 4; ++a)
#pragma unroll
    for (int b = 0; b < QT; ++b) acc[a][b] = (f32x4){0.f, 0.f, 0.f, 0.f};
  u32x4 pr[4], qr[8];
  gemm_load<QMODE>(pr, qr, W, q, m0, 0, tid);
#pragma unroll 1
  for (int kt = 0; kt < 16; ++kt) {
    __syncthreads();
    {
      u16* wb = Ps + (tid >> 3) * LDS_STRIDE + (tid & 7) * 8;
#pragma unroll
      for (int i = 0; i < 4; ++i) *(u32x4*)(wb + i * 32 * LDS_STRIDE) = pr[i];
#pragma unroll
      for (int i = 0; i < 8; ++i) *(u32x4*)(wb + (128 + i * 32) * LDS_STRIDE) = qr[i];
    }
    __syncthreads();
    if (kt + 1 < 16) gemm_load<QMODE>(pr, qr, W, q, m0, (kt + 1) * 64, tid);
#pragma unroll
    for (int ks = 0; ks < 2; ++ks) {
      bf16x8 pf[4];
#pragma unroll
      for (int i = 0; i < 4; ++i) pf[i] = *(const bf16x8*)(Ps + (wn * 64 + i * 16 + l15) * LDS_STRIDE + ks * 32 + quad * 8);
#pragma unroll
      for (int hb = 0; hb < 2; ++hb) {
        bf16x8 qf[4];
#pragma unroll
        for (int i = 0; i < 4; ++i) qf[i] = *(const bf16x8*)(Qs + (wq * 128 + (hb * 4 + i) * 16 + l15) * LDS_STRIDE + ks * 32 + quad * 8);
        __builtin_amdgcn_sched_barrier(0);
#pragma unroll
        for (int a = 0; a < 4; ++a)
#pragma unroll
          for (int b = 0; b < 4; ++b) acc[a][hb * 4 + b] = mfma16(pf[a], qf[b], acc[a][hb * 4 + b]);
        __builtin_amdgcn_sched_barrier(0);
      }
    }
  }
}

DI void g1_tile(const Params& p, int L, int tile, u16* smem) {
  int mt, nt;
  {
    const int xcd = tile & 7, lb = (tile & 511) >> 3, rnd = tile >> 9;
    const int j = lb + 64 * rnd;
    if (j >= 800) return;
    const int mg = j / 200, r = j % 200;
    int mi;
    if (r < 192) { const int rr = r & 63; mi = rr & 7; nt = (r >> 6) * 8 + (rr >> 3); } else { mi = r - 192; nt = 24; }
    mt = xcd * 32 + mg * 8 + mi;
  }
  const int m0 = mt * TM, n0 = nt * 128;
  const int tid = otid(), lane = tid & 63, wave = tid >> 6;
  const int wn = wave & 1, wq = wave >> 1, l15 = lane & 15, quad = lane >> 4;
  float* rstd_s = (float*)(smem + 384 * LDS_STRIDE);
  __syncthreads();
  {
    const float4* s = (const float4*)((const float*)(p.ws + OFF_SUMSQ) + (size_t)(m0 + tid) * 16);
    float4 a = s[0], b = s[1], c = s[2], d = s[3];
    float ss = a.x + a.y + a.z + a.w + b.x + b.y + b.z + b.w + c.x + c.y + c.z + c.w + d.x + d.y + d.z + d.w;
    rstd_s[tid] = rsqrtf(ss * (1.f / 1024.f) + EPSF);
  }
  f32x4 acc[4][QT];
  QSrc q; q.base = p.out; q.ldq = 1024;
  const u16* W = (const u16*)(p.ws + OFF_WIN) + ((size_t)L * NPAD + n0) * 1024;
  gemm_core<0>(acc, W, q, m0, smem);
  float rs[QT];
#pragma unroll
  for (int qt = 0; qt < QT; ++qt) rs[qt] = rstd_s[wq * 128 + qt * 16 + l15];
#pragma unroll
  for (int a = 0; a < 4; ++a)
#pragma unroll
    for (int b = 0; b < QT; ++b)
#pragma unroll
      for (int j = 0; j < 4; ++j) acc[a][b][j] *= rs[b];
  const int seq = seq_of_token(m0), sbase = seq_base(seq), slen = seq_len(seq);
  if (nt <= 2) {
    const float* g = (nt <= 1 ? p.att_q_norm_g : p.att_k_norm_g) + L * 64;
    const float* rope = (const float*)(p.ws + OFF_ROPE);
    const float qscale = nt <= 1 ? 0.125f * 1.4426950408889634f : 1.f;
    u16* dst = nt <= 1 ? (u16*)(p.ws + OFF_C0) : (u16*)(p.ws + OFF_AK);
    const int dstride = nt <= 1 ? 256 : 128;
    const int colbase = (nt <= 1 ? nt * 128 : 0) + wn * 64;
#pragma unroll
    for (int qt = 0; qt < QT; ++qt) {
      int token = m0 + wq * 128 + qt * 16 + l15;
      int tpos = token - sbase;
      int prow = tpos >> 6, pcol = tpos & 63;
      float ss = 0.f;
#pragma unroll
      for (int pt = 0; pt < 4; ++pt)
#pragma unroll
        for (int j = 0; j < 4; ++j) ss += acc[pt][qt][j] * acc[pt][qt][j];
      ss += __shfl_xor(ss, 16); ss += __shfl_xor(ss, 32);
      float r = rsqrtf(ss * (1.f / 64.f) + EPSF);
      float v[4][4];
#pragma unroll
      for (int pt = 0; pt < 4; ++pt)
#pragma unroll
        for (int j = 0; j < 4; ++j) v[pt][j] = acc[pt][qt][j] * r * g[pt * 16 + quad * 4 + j];
#pragma unroll
      for (int ax = 0; ax < 2; ++ax) {
        int pos = ax == 0 ? prow : pcol;
#pragma unroll
        for (int j = 0; j < 4; ++j) {
          float c = rope[pos * 16 + quad * 4 + j], s = rope[1024 + pos * 16 + quad * 4 + j];
          float x1 = v[2 * ax][j], x2 = v[2 * ax + 1][j];
          v[2 * ax][j] = (x1 * c - x2 * s) * qscale;
          v[2 * ax + 1][j] = (x2 * c + x1 * s) * qscale;
        }
      }
#pragma unroll
      for (int pt = 0; pt < 4; ++pt)
        *(uint2*)(dst + (size_t)token * dstride + colbase + pt * 16 + quad * 4) = make_uint2(pack2(v[pt][0], v[pt][1]), pack2(v[pt][2], v[pt][3]));
    }
  } else if (nt == 3) {
    u16* AVT = (u16*)(p.ws + OFF_AVT) + (size_t)sbase * 128;
#pragma unroll
    for (int qt = 0; qt < QT; ++qt) {
      int tpos = m0 + wq * 128 + qt * 16 + l15 - sbase;
#pragma unroll
      for (int pt = 0; pt < 4; ++pt)
#pragma unroll
        for (int j = 0; j < 4; ++j) {
          int n = wn * 64 + pt * 16 + quad * 4 + j;
          AVT[(size_t)n * slen + tpos] = f2bf(acc[pt][qt][j]);
        }
    }
  } else if (nt == 24) {
    float* SMALL = (float*)(p.ws + OFF_SMALL);
    if (wn == 0) {
#pragma unroll
      for (int qt = 0; qt < QT; ++qt) {
        int token = m0 + wq * 128 + qt * 16 + l15;
#pragma unroll
        for (int pt = 0; pt < 3; ++pt)
          *(float4*)(SMALL + (size_t)token * 48 + pt * 16 + quad * 4) = make_float4(acc[pt][qt][0], acc[pt][qt][1], acc[pt][qt][2], acc[pt][qt][3]);
      }
    }
  } else {
    u16* dst; int dstride, colbase; int mode = 0;
    const float* gvec = nullptr;
    if (nt <= 5) { dst = (u16*)(p.ws + OFF_AGATE); dstride = 256; colbase = (nt - 4) * 128; mode = 1; }
    else if (nt <= 11) { dst = (u16*)(p.ws + OFF_DQKV); dstride = 768; colbase = (nt - 6) * 128; }
    else if (nt <= 13) { dst = (u16*)(p.ws + OFF_DGATE); dstride = 256; colbase = (nt - 12) * 128; mode = 1; gvec = p.gdn_out_norm_g + L * 64; }
    else if (nt == 14) { dst = (u16*)(p.ws + OFF_LQ); dstride = 128; colbase = 0; }
    else if (nt == 15) { dst = (u16*)(p.ws + OFF_LK); dstride = 128; colbase = 0; }
    else if (nt <= 17) { dst = (u16*)(p.ws + OFF_LV); dstride = 256; colbase = (nt - 16) * 128; }
    else if (nt <= 19) { dst = (u16*)(p.ws + OFF_LGATE); dstride = 256; colbase = (nt - 18) * 128; mode = 1; gvec = p.gla_out_norm_g + L * 64; }
    else if (nt <= 21) { dst = (u16*)(p.ws + OFF_C3); dstride = 256; colbase = (nt - 20) * 128; mode = 2; }
    else { dst = (u16*)(p.ws + OFF_MGATE); dstride = 256; colbase = (nt - 22) * 128; mode = 1; }
    u16* bp = dst + (size_t)(m0 + wq * 128 + l15) * dstride + colbase + wn * 64 + quad * 4;
    const bool is_dqkv = (nt >= 6 && nt <= 11);
    u16* halo = (u16*)(p.ws + OFF_HALO) + (size_t)(mt * 2 + wq) * 2 * 768 + colbase + wn * 64 + quad * 4;
#pragma unroll
    for (int qt = 0; qt < QT; ++qt) {
      u16* rp = bp + (size_t)(qt * 16) * dstride;
#pragma unroll
      for (int pt = 0; pt < 4; ++pt) {
        float v[4];
#pragma unroll
        for (int j = 0; j < 4; ++j) {
          float x = acc[pt][qt][j];
          v[j] = mode == 1 ? siluf(x) : (mode == 2 ? x * (0.125f * 1.4426950408889634f) : x);
        }
        if (gvec) {
          float4 gg = *(const float4*)(gvec + pt * 16 + quad * 4);
          v[0] *= gg.x; v[1] *= gg.y; v[2] *= gg.z; v[3] *= gg.w;
        }
        u32x2 pk = {pack2(v[0], v[1]), pack2(v[2], v[3])};
        __builtin_nontemporal_store(pk, (u32x2*)(rp + pt * 16));
        if (is_dqkv) {
          if (qt == 0 && l15 == 0) *(u32x2*)(halo + pt * 16) = pk;
          if (qt == QT - 1 && l15 == 15) *(u32x2*)(halo + 768 + pt * 16) = pk;
        }
      }
    }
  }
}

DI void g3_tile(const Params& p, int L, int tile, u16* smem) {
  const int mt = tile >> 2, nt = tile & 3;
  const int m0 = mt * TM, n0 = nt * 128;
  const int tid = otid(), lane = tid & 63, wave = tid >> 6;
  const int wn = wave & 1, wq = wave >> 1, l15 = lane & 15, quad = lane >> 4;
  float* rstd_s = (float*)(smem + 384 * LDS_STRIDE);
  __syncthreads();
  rstd_s[tid] = ((const float*)(p.ws + OFF_MEMRSTD))[m0 + tid];
  f32x4 acc[4][QT];
  QSrc q; int mloc;
  if (m0 < 2048) { q.base = p.mem_prompt; mloc = m0; } else { q.base = p.mem_sample; mloc = m0 - 2048; }
  q.ldq = 1024;
  const u16* W = (const u16*)(p.ws + OFF_WMKV) + ((size_t)L * 512 + n0) * 1024;
  gemm_core<1>(acc, W, q, mloc, smem);
  u16* KM = (u16*)(p.ws + OFF_KM);
  u16* VMT = (u16*)(p.ws + OFF_VMT);
#pragma unroll
  for (int qt = 0; qt < QT; ++qt) {
    int r = m0 + wq * 128 + qt * 16 + l15;
    float rs = rstd_s[wq * 128 + qt * 16 + l15];
    int b = r >> 8, m = r & 255;
#pragma unroll
    for (int pt = 0; pt < 4; ++pt) {
      int n = n0 + wn * 64 + pt * 16 + quad * 4;
      if (n < 256) {
        *(uint2*)(KM + (size_t)r * 256 + n) = make_uint2(pack2(acc[pt][qt][0] * rs, acc[pt][qt][1] * rs), pack2(acc[pt][qt][2] * rs, acc[pt][qt][3] * rs));
      } else {
#pragma unroll
        for (int j = 0; j < 4; ++j) {
          int nn = n + j - 256;
          VMT[((size_t)b * 256 + nn) * 256 + m] = f2bf(acc[pt][qt][j] * rs);
        }
      }
    }
  }
}

DI void g2_tile(const Params& p, int L, int tile, u16* smem) {
  int mt, nt;
  {
    const int xcd = tile & 7, lb = (tile & 511) >> 3, rnd = tile >> 9;
    const int j = lb + 64 * rnd;
    const int rr = j & 63;
    mt = xcd * 32 + (j >> 6) * 8 + (rr & 7); nt = rr >> 3;
  }
  const int m0 = mt * TM, n0 = nt * 128;
  const int tid = otid(), lane = tid & 63, wave = tid >> 6;
  const int wn = wave & 1, wq = wave >> 1, l15 = lane & 15, quad = lane >> 4;
  f32x4 acc[4][QT];
  QSrc q; q.base = nullptr; q.ldq = 0;
  q.c0 = (const u16*)(p.ws + OFF_C0); q.c1 = (const u16*)(p.ws + OFF_C1);
  q.c2 = (const u16*)(p.ws + OFF_C2); q.c3 = (const u16*)(p.ws + OFF_C3);
  const u16* W = (const u16*)(p.ws + OFF_WOUT) + ((size_t)L * 1024 + n0) * 1024;
  gemm_core<2>(acc, W, q, m0, smem);
  u16* HI = (u16*)p.out; u16* LO = HI + (size_t)T_TOK * 1024;
  float* SUMSQ = (float*)(p.ws + OFF_SUMSQ);
  float* HF = (float*)(p.ws + OFF_HFINAL);
#pragma unroll
  for (int qt = 0; qt < QT; ++qt) {
    int token = m0 + wq * 128 + qt * 16 + l15;
    float ss = 0.f;
#pragma unroll
    for (int pt = 0; pt < 4; ++pt) {
      int n = n0 + wn * 64 + pt * 16 + quad * 4;
      size_t idx = (size_t)token * 1024 + n;
      uint2 h = *(const uint2*)(HI + idx);
      float v[4];
      v[0] = bf2f(h.x & 0xffff) + acc[pt][qt][0];
      v[1] = bf2f(h.x >> 16) + acc[pt][qt][1];
      v[2] = bf2f(h.y & 0xffff) + acc[pt][qt][2];
      v[3] = bf2f(h.y >> 16) + acc[pt][qt][3];
#pragma unroll
      for (int j = 0; j < 4; ++j) ss += v[j] * v[j];
      if (L == 3) {
        *(float4*)(HF + idx) = make_float4(v[0], v[1], v[2], v[3]);
      } else {
        *(uint2*)(HI + idx) = make_uint2(pack2(v[0], v[1]), pack2(v[2], v[3]));
      }
    }
    ss += __shfl_xor(ss, 16); ss += __shfl_xor(ss, 32);
    if (quad == 0) SUMSQ[(size_t)token * 16 + nt * 2 + wn] = ss;
  }
}

DI void attn_block(u16* Qp, const u16* Kp, int kstride, const u16* VTp, int Lk, const u16* Gp, u16* smem) {
  const int tid = otid(), lane = tid & 63, wave = tid >> 6;
  const int l15 = lane & 15, quad = lane >> 4;
  u16* Ks = smem; u16* Vs = smem + 64 * LDS_STRIDE;
  bf16x8 qf[2][2];
#pragma unroll
  for (int qt = 0; qt < 2; ++qt)
#pragma unroll
    for (int ks = 0; ks < 2; ++ks)
      qf[qt][ks] = *(const bf16x8*)(Qp + (size_t)(wave * 32 + qt * 16 + l15) * 256 + ks * 32 + quad * 8);
  f32x4 o[4][2];
#pragma unroll
  for (int a = 0; a < 4; ++a)
#pragma unroll
    for (int b = 0; b < 2; ++b) o[a][b] = (f32x4){0.f, 0.f, 0.f, 0.f};
  float mrun[2] = {-1e30f, -1e30f}, lsum[2] = {0.f, 0.f};
  u32x4 kr[2], vr[2];
  const int nkt = Lk >> 6;
#pragma unroll
  for (int i = 0; i < 2; ++i) {
    int c = tid + 256 * i; int row = c >> 3, kc = c & 7;
    kr[i] = *(const u32x4*)(Kp + (size_t)row * kstride + kc * 8);
    vr[i] = *(const u32x4*)(VTp + (size_t)row * Lk + kc * 8);
  }
#pragma unroll 1
  for (int kt = 0; kt < nkt; ++kt) {
    __syncthreads();
#pragma unroll
    for (int i = 0; i < 2; ++i) {
      int c = tid + 256 * i; int row = c >> 3, kc = c & 7;
      *(u32x4*)(Ks + row * LDS_STRIDE + kc * 8) = kr[i];
      *(u32x4*)(Vs + row * LDS_STRIDE + kc * 8) = vr[i];
    }
    __syncthreads();
    if (kt + 1 < nkt) {
      int key0 = (kt + 1) * 64;
#pragma unroll
      for (int i = 0; i < 2; ++i) {
        int c = tid + 256 * i; int row = c >> 3, kc = c & 7;
        kr[i] = *(const u32x4*)(Kp + (size_t)(key0 + row) * kstride + kc * 8);
        vr[i] = *(const u32x4*)(VTp + (size_t)row * Lk + key0 + kc * 8);
      }
    }
    f32x4 s[4][2];
#pragma unroll
    for (int a = 0; a < 4; ++a)
#pragma unroll
      for (int b = 0; b < 2; ++b) s[a][b] = (f32x4){0.f, 0.f, 0.f, 0.f};
#pragma unroll
    for (int ks = 0; ks < 2; ++ks)
#pragma unroll
      for (int k4 = 0; k4 < 4; ++k4) {
        bf16x8 kf = *(const bf16x8*)(Ks + (k4 * 16 + l15) * LDS_STRIDE + ks * 32 + quad * 8);
#pragma unroll
        for (int qt = 0; qt < 2; ++qt) s[k4][qt] = mfma16(kf, qf[qt][ks], s[k4][qt]);
      }
    bf16x8 pq[2][2];
#pragma unroll
    for (int qt = 0; qt < 2; ++qt) {
      float mx = -1e30f;
#pragma unroll
      for (int k4 = 0; k4 < 4; ++k4)
#pragma unroll
        for (int j = 0; j < 4; ++j) mx = fmaxf(mx, s[k4][qt][j]);
      mx = fmaxf(mx, __shfl_xor(mx, 16)); mx = fmaxf(mx, __shfl_xor(mx, 32));
      float mn = fmaxf(mrun[qt], mx);
      float alpha = fast_exp2(mrun[qt] - mn);
      mrun[qt] = mn;
      float ps = 0.f;
#pragma unroll
      for (int k4 = 0; k4 < 4; ++k4)
#pragma unroll
        for (int j = 0; j < 4; ++j) { float e = fast_exp2(s[k4][qt][j] - mn); s[k4][qt][j] = e; ps += e; }
      lsum[qt] = lsum[qt] * alpha + ps;
#pragma unroll
      for (int dt = 0; dt < 4; ++dt)
#pragma unroll
        for (int j = 0; j < 4; ++j) o[dt][qt][j] *= alpha;
#pragma unroll
      for (int k2 = 0; k2 < 2; ++k2) {
        u32x4 u = (u32x4){pack2(s[2 * k2][qt][0], s[2 * k2][qt][1]), pack2(s[2 * k2][qt][2], s[2 * k2][qt][3]),
                          pack2(s[2 * k2 + 1][qt][0], s[2 * k2 + 1][qt][1]), pack2(s[2 * k2 + 1][qt][2], s[2 * k2 + 1][qt][3])};
        pq[qt][k2] = __builtin_bit_cast(bf16x8, u);
      }
    }
#pragma unroll
    for (int dt = 0; dt < 4; ++dt)
#pragma unroll
      for (int k2 = 0; k2 < 2; ++k2) {
        const u16* vrow = Vs + (dt * 16 + l15) * LDS_STRIDE + quad * 4;
        u32x2 a = *(const u32x2*)(vrow + (2 * k2) * 16), b = *(const u32x2*)(vrow + (2 * k2 + 1) * 16);
        bf16x8 vf = __builtin_bit_cast(bf16x8, (u32x4){a.x, a.y, b.x, b.y});
#pragma unroll
        for (int qt = 0; qt < 2; ++qt) o[dt][qt] = mfma16(vf, pq[qt][k2], o[dt][qt]);
      }
  }
#pragma unroll
  for (int qt = 0; qt < 2; ++qt) {
    float l = lsum[qt];
    l += __shfl_xor(l, 16); l += __shfl_xor(l, 32);
    float inv = 1.f / l;
    size_t rowoff = (size_t)(wave * 32 + qt * 16 + l15) * 256;
#pragma unroll
    for (int dt = 0; dt < 4; ++dt) {
      uint2 g = *(const uint2*)(Gp + rowoff + dt * 16 + quad * 4);
      float v0 = o[dt][qt][0] * inv * bf2f(g.x & 0xffff), v1 = o[dt][qt][1] * inv * bf2f(g.x >> 16);
      float v2 = o[dt][qt][2] * inv * bf2f(g.y & 0xffff), v3 = o[dt][qt][3] * inv * bf2f(g.y >> 16);
      *(uint2*)(Qp + rowoff + dt * 16 + quad * 4) = make_uint2(pack2(v0, v1), pack2(v2, v3));
    }
  }
}

DI float softplusf(float x) { return fmaxf(x, 0.f) + flog(1.f + fexp(-fabsf(x))); }
DI float logsigmoidf(float x) { return fminf(x, 0.f) - flog(1.f + fexp(-fabsf(x))); }

DI void scan_block_naive(const Params& p, int L, int seq, int h, u16* smem) {
  const int tid = otid(), lane = tid & 63, wave = tid >> 6;
  const int dir = wave & 1, kind = wave >> 1;
  const int sbase = seq_base(seq), S = seq_len(seq);
  float* bc = (float*)smem + wave * 160;
  const u16* DQKV = (const u16*)(p.ws + OFF_DQKV) + (size_t)sbase * 768 + h * 64 + lane;
  const float* SMALL = (const float*)(p.ws + OFF_SMALL) + (size_t)sbase * 48;
  float St[64];
#pragma unroll
  for (int d = 0; d < 64; ++d) St[d] = 0.f;
  float cw[3][3];
#pragma unroll
  for (int i = 0; i < 3; ++i)
#pragma unroll
    for (int s = 0; s < 3; ++s) cw[i][s] = p.gdn_conv_w[((size_t)L * 3 + i) * 768 + s * 256 + h * 64 + lane];
  const float A = fexp(p.gdn_a_log[L * 8 + dir * 4 + h]);
  const float dtb = p.gdn_dt_bias[L * 8 + dir * 4 + h];
  const float onorm = (kind == 0 ? p.gdn_out_norm_g : p.gla_out_norm_g)[L * 64 + lane];
  float wup[16]; float bg = 0.f;
  {
    int d = lane & 31;
#pragma unroll
    for (int r = 0; r < 16; ++r) wup[r] = p.gla_w_gate_up[(((size_t)L * 2 + dir) * 16 + r) * 128 + h * 32 + d];
    bg = p.gla_b_gate[((size_t)L * 2 + dir) * 128 + h * 32 + d];
  }
  u16* OUT = (u16*)(p.ws + (kind == 0 ? OFF_C1 : OFF_C2)) + (size_t)sbase * 256 + h * 64 + lane;
  const u16* GATE = (const u16*)(p.ws + (kind == 0 ? OFF_DGATE : OFF_LGATE)) + (size_t)sbase * 256 + h * 64 + lane;
  const u16* LQ = (const u16*)(p.ws + OFF_LQ) + (size_t)sbase * 128 + h * 32;
  const u16* LK = (const u16*)(p.ws + OFF_LK) + (size_t)sbase * 128 + h * 32;
  const u16* LV = (const u16*)(p.ws + OFF_LV) + (size_t)sbase * 256 + h * 64 + lane;
  const int step = dir ? -1 : 1;
  int t = dir ? S - 1 : 0;
  float rb[3], r0[3], r1[3], r2[3];
#pragma unroll
  for (int s = 0; s < 3; ++s) {
    rb[s] = 0.f;
    r0[s] = bf2f(DQKV[(size_t)t * 768 + s * 256]);
    r1[s] = bf2f(DQKV[(size_t)(t + step) * 768 + s * 256]);
    r2[s] = bf2f(DQKV[(size_t)(t + 2 * step) * 768 + s * 256]);
  }
#pragma unroll 1
  for (int n = 0; n < S; ++n, t += step) {
    float o;
    if (kind == 0) {
      float cv[3];
#pragma unroll
      for (int s = 0; s < 3; ++s) {
        float xm = dir ? r1[s] : rb[s], xp = dir ? rb[s] : r1[s];
        cv[s] = siluf(xm * cw[0][s] + r0[s] * cw[1][s] + xp * cw[2][s]);
      }
      float ssq = wave_sum(cv[0] * cv[0]), ssk = wave_sum(cv[1] * cv[1]);
      float qn = cv[0] * rsqrtf(ssq + EPSF), kn = cv[1] * rsqrtf(ssk + EPSF);
      bc[lane] = qn; bc[64 + lane] = kn;
      float beta = 1.f / (1.f + fexp(-SMALL[(size_t)t * 48 + dir * 4 + h]));
      float g = -A * softplusf(SMALL[(size_t)t * 48 + 8 + dir * 4 + h] + dtb);
      float eg = fexp(g);
#pragma unroll
      for (int s = 0; s < 3; ++s) { rb[s] = r0[s]; r0[s] = r1[s]; r1[s] = r2[s]; }
      int tn = t + 3 * step;
      bool ok = tn >= 0 && tn < S;
#pragma unroll
      for (int s = 0; s < 3; ++s) r2[s] = ok ? bf2f(DQKV[(size_t)tn * 768 + s * 256]) : 0.f;
      __builtin_amdgcn_wave_barrier();
      float kS = 0.f;
#pragma unroll
      for (int d4 = 0; d4 < 16; ++d4) {
        float4 kk = *(const float4*)(bc + 64 + d4 * 4);
        kS += kk.x * St[d4 * 4] + kk.y * St[d4 * 4 + 1] + kk.z * St[d4 * 4 + 2] + kk.w * St[d4 * 4 + 3];
      }
      float w = beta * (cv[2] - eg * kS);
      o = 0.f;
#pragma unroll
      for (int d4 = 0; d4 < 16; ++d4) {
        float4 kk = *(const float4*)(bc + 64 + d4 * 4);
        float4 qq = *(const float4*)(bc + d4 * 4);
        St[d4 * 4] = eg * St[d4 * 4] + kk.x * w; o += qq.x * St[d4 * 4];
        St[d4 * 4 + 1] = eg * St[d4 * 4 + 1] + kk.y * w; o += qq.y * St[d4 * 4 + 1];
        St[d4 * 4 + 2] = eg * St[d4 * 4 + 2] + kk.z * w; o += qq.z * St[d4 * 4 + 2];
        St[d4 * 4 + 3] = eg * St[d4 * 4 + 3] + kk.w * w; o += qq.w * St[d4 * 4 + 3];
      }
      o *= 0.125f;
      __builtin_amdgcn_wave_barrier();
    } else {
      float lg = bg;
      const float* low = SMALL + (size_t)t * 48 + 16 + dir * 16;
#pragma unroll
      for (int r = 0; r < 16; ++r) lg += low[r] * wup[r];
      float egk = fexp(logsigmoidf(lg) * (1.f / 16.f));
      float qk = lane < 32 ? bf2f(LQ[(size_t)t * 128 + lane]) : bf2f(LK[(size_t)t * 128 + lane - 32]);
      float v = bf2f(LV[(size_t)t * 256]);
      bc[lane] = qk;
      if (lane < 32) bc[64 + lane] = egk;
      __builtin_amdgcn_wave_barrier();
      o = 0.f;
#pragma unroll
      for (int d4 = 0; d4 < 8; ++d4) {
        float4 qq = *(const float4*)(bc + d4 * 4);
        float4 kk = *(const float4*)(bc + 32 + d4 * 4);
        float4 ee = *(const float4*)(bc + 64 + d4 * 4);
        St[d4 * 4] = ee.x * St[d4 * 4] + kk.x * v; o += qq.x * St[d4 * 4];
        St[d4 * 4 + 1] = ee.y * St[d4 * 4 + 1] + kk.y * v; o += qq.y * St[d4 * 4 + 1];
        St[d4 * 4 + 2] = ee.z * St[d4 * 4 + 2] + kk.z * v; o += qq.z * St[d4 * 4 + 2];
        St[d4 * 4 + 3] = ee.w * St[d4 * 4 + 3] + kk.w * v; o += qq.w * St[d4 * 4 + 3];
      }
      o *= 0.17677669529663687f;
      __builtin_amdgcn_wave_barrier();
    }
    if (n < (S >> 1)) {
      OUT[(size_t)t * 256] = f2bf(o);
    } else {
      float tot = o + bf2f(OUT[(size_t)t * 256]);
      float ss = wave_sum(tot * tot);
      float y = tot * rsqrtf(ss * (1.f / 64.f) + EPSF) * onorm * bf2f(GATE[(size_t)t * 256]);
      OUT[(size_t)t * 256] = f2bf(y);
    }
    __syncthreads();
  }
}

DI void conv_load32(float (&x)[32], const u16* src) {
#pragma unroll
  for (int i = 0; i < 4; ++i) {
    u32x4 r = *(const u32x4*)(src + i * 8);
#pragma unroll
    for (int j = 0; j < 4; ++j) { x[i * 8 + 2 * j] = bf2f(r[j] & 0xffff); x[i * 8 + 2 * j + 1] = bf2f(r[j] >> 16); }
  }
}
DI void prep_task(const Params& p, int L, int task, u16* smem) {
  const int mt = task >> 2, h = task & 3;
  const int m0 = mt * 128;
  const int tid = otid(), tok = tid >> 1, half = tid & 1;
  const int seq = seq_of_token(m0), sbase = seq_base(seq), S = seq_len(seq);
  const int token = m0 + tok, tpos = token - sbase;
  u16* DQ = (u16*)(p.ws + OFF_DQKV);
  const u16* HALO = (const u16*)(p.ws + OFF_HALO);
  u16* LV = (u16*)(p.ws + OFF_LV);
  u32x4 raw[3][3][4];
  const float scp = tpos > 0 ? 1.f : 0.f, scn = tpos < S - 1 ? 1.f : 0.f;
#pragma unroll
  for (int s = 0; s < 3; ++s) {
    const int col0 = s * 256 + h * 64 + half * 32;
    const u16* pc = DQ + (size_t)token * 768 + col0;
    const u16* pp = tpos > 0 ? (tok > 0 ? pc - 768 : HALO + ((size_t)(mt - 1) * 2 + 1) * 768 + col0) : pc;
    const u16* pn = tpos < S - 1 ? (tok < 127 ? pc + 768 : HALO + ((size_t)(mt + 1) * 2 + 0) * 768 + col0) : pc;
#pragma unroll
    for (int i = 0; i < 4; ++i) { raw[s][0][i] = *(const u32x4*)(pp + i * 8); raw[s][1][i] = *(const u32x4*)(pc + i * 8); raw[s][2][i] = *(const u32x4*)(pn + i * 8); }
  }
  u32x4 res[3][4];
#pragma unroll
  for (int s = 0; s < 3; ++s) {
    const int col0 = s * 256 + h * 64 + half * 32;
    const float* w0 = p.gdn_conv_w + ((size_t)L * 3 + 0) * 768 + col0;
    const float* w1 = w0 + 768; const float* w2 = w0 + 2 * 768;
    float acc[32];
#pragma unroll
    for (int i = 0; i < 4; ++i)
#pragma unroll
      for (int j = 0; j < 4; ++j) {
        const int c = i * 8 + 2 * j;
        const uint32_t rp = raw[s][0][i][j], rc = raw[s][1][i][j], rn = raw[s][2][i][j];
        acc[c] = bf2f(rc & 0xffff) * w1[c] + scp * (bf2f(rp & 0xffff) * w0[c]) + scn * (bf2f(rn & 0xffff) * w2[c]);
        acc[c + 1] = bf2f(rc >> 16) * w1[c + 1] + scp * (bf2f(rp >> 16) * w0[c + 1]) + scn * (bf2f(rn >> 16) * w2[c + 1]);
      }
    float ss = 0.f;
#pragma unroll
    for (int c = 0; c < 32; ++c) { acc[c] = siluf(acc[c]); ss += acc[c] * acc[c]; }
    float sc = 1.f;
    if (s < 2) { ss += __shfl_xor(ss, 1); sc = rsqrtf(ss + EPSF); }
#pragma unroll
    for (int i = 0; i < 4; ++i)
      res[s][i] = (u32x4){pack2(acc[i * 8] * sc, acc[i * 8 + 1] * sc), pack2(acc[i * 8 + 2] * sc, acc[i * 8 + 3] * sc),
                          pack2(acc[i * 8 + 4] * sc, acc[i * 8 + 5] * sc), pack2(acc[i * 8 + 6] * sc, acc[i * 8 + 7] * sc)};
  }
  __syncthreads();
#pragma unroll
  for (int s = 0; s < 3; ++s)
#pragma unroll
    for (int i = 0; i < 4; ++i) *(u32x4*)(DQ + (size_t)token * 768 + s * 256 + h * 64 + half * 32 + i * 8) = res[s][i];
}

DI bf16x8 pk8(f32x4 a, f32x4 b) { u32x4 u = {pack2(a[0], a[1]), pack2(a[2], a[3]), pack2(b[0], b[1]), pack2(b[2], b[3])}; return __builtin_bit_cast(bf16x8, u); }
DI bf16x8 pk4(f32x4 a) { u32x4 u = {pack2(a[0], a[1]), pack2(a[2], a[3]), 0u, 0u}; return __builtin_bit_cast(bf16x8, u); }
DI bf16x8 pk8n(f32x4 a, f32x4 b) { u32x4 u = {pack2(-a[0], -a[1]), pack2(-a[2], -a[3]), pack2(-b[0], -b[1]), pack2(-b[2], -b[3])}; return __builtin_bit_cast(bf16x8, u); }
DI u32x2 rev4(u32x2 v) { u32x2 r = {(v.y >> 16) | (v.y << 16), (v.x >> 16) | (v.x << 16)}; return r; }
DI f32x4 unpack4(u32x2 v) { f32x4 r = {bf2f(v.x & 0xffff), bf2f(v.x >> 16), bf2f(v.y & 0xffff), bf2f(v.y >> 16)}; return r; }
#define F4Z ((f32x4){0.f, 0.f, 0.f, 0.f})

DI void scan_combine(u16* OUT, const u16* SLOT, int slot_stride, const u16* GATE, int S, int tid) {
  const int q4 = (tid & 3) * 16;
#pragma unroll 1
  for (int t0 = 0; t0 < S; t0 += 128) {
    u32x4 a[2][2], b[2][2], g[2][2];
#pragma unroll
    for (int k = 0; k < 2; ++k) {
      size_t tok = (size_t)(t0 + k * 64 + (tid >> 2));
#pragma unroll
      for (int i = 0; i < 2; ++i) {
        a[k][i] = *(const u32x4*)(OUT + tok * 256 + q4 + i * 8);
        b[k][i] = *(const u32x4*)(SLOT + tok * slot_stride + q4 + i * 8);
        g[k][i] = *(const u32x4*)(GATE + tok * 256 + q4 + i * 8);
      }
    }
#pragma unroll
    for (int k = 0; k < 2; ++k) {
      size_t tok = (size_t)(t0 + k * 64 + (tid >> 2));
      float v[16]; float ss = 0.f;
#pragma unroll
      for (int i = 0; i < 2; ++i)
#pragma unroll
        for (int w = 0; w < 4; ++w) {
          float x0 = bf2f(a[k][i][w] & 0xffff) + bf2f(b[k][i][w] & 0xffff), x1 = bf2f(a[k][i][w] >> 16) + bf2f(b[k][i][w] >> 16);
          v[i * 8 + w * 2] = x0; v[i * 8 + w * 2 + 1] = x1; ss += x0 * x0 + x1 * x1;
        }
      ss += __shfl_xor(ss, 1); ss += __shfl_xor(ss, 2);
      const float r = rsqrtf(ss * (1.f / 64.f) + EPSF);
#pragma unroll
      for (int i = 0; i < 2; ++i) {
        u32x4 o;
#pragma unroll
        for (int w = 0; w < 4; ++w)
          o[w] = pack2(v[i * 8 + w * 2] * r * bf2f(g[k][i][w] & 0xffff), v[i * 8 + w * 2 + 1] * r * bf2f(g[k][i][w] >> 16));
        *(u32x4*)(OUT + tok * 256 + q4 + i * 8) = o;
      }
    }
  }
}

#define SCAN_R 2
#define SCAN_SLOT_V4 10
DI void ring_wait(volatile int* f, int v) { while (*f < v) __builtin_amdgcn_s_sleep(1); }

DI void dn_task(const Params& p, int L, int seq, int h, u16* smem) {
  const int tid = otid(), lane = tid & 63, wave = tid >> 6, l15 = lane & 15, quad = lane >> 4;
  const int dir = wave >> 1, role = wave & 1;
  const int sbase = seq_base(seq), S = seq_len(seq), N = S >> 4;
  u32x4* slots = (u32x4*)smem + (size_t)dir * SCAN_R * SCAN_SLOT_V4 * 64 + lane;
  volatile int* ready = (volatile int*)(smem + 20480) + dir * 8;
  volatile int* done = ready + 4;
  __syncthreads();
  if (tid < 16) ((volatile int*)(smem + 20480))[tid] = 0;
  __syncthreads();
  u16* OUT = (u16*)(p.ws + OFF_C1) + (size_t)sbase * 256 + h * 64;
  u16* SLOT = (u16*)(p.ws + OFF_DQKV) + (size_t)sbase * 768 + h * 64;
  if (role == 0) {
    const u16* QK = (const u16*)(p.ws + OFF_DQKV) + (size_t)sbase * 768 + h * 64;
    const float* SM = (const float*)(p.ws + OFF_SMALL) + (size_t)sbase * 48 + dir * 4 + h;
    const float A = fexp(p.gdn_a_log[L * 8 + dir * 4 + h]);
    const float dtb = p.gdn_dt_bias[L * 8 + dir * 4 + h];
    bf16x8 selE, selO;
    {
      uint32_t w = ((l15 >> 2) == quad) ? (0x3F80u << ((l15 & 1) * 16)) : 0u;
      uint32_t w0 = (l15 & 2) ? 0u : w, w1 = (l15 & 2) ? w : 0u;
      selE = __builtin_bit_cast(bf16x8, (u32x4){w0, w1, 0u, 0u});
      selO = __builtin_bit_cast(bf16x8, (u32x4){0u, 0u, w0, w1});
    }
    const int ca0 = dir ? 12 - quad * 4 : quad * 4;
    u32x2 qraw[4], kraw[4], vraw[4]; float braw, graw;
    auto load_step = [&](int n) {
      int t0 = dir ? S - 16 * (n + 1) : 16 * n;
      int rl = dir ? t0 + 15 - l15 : t0 + l15;
      const u16* qrow = QK + (size_t)rl * 768;
#pragma unroll
      for (int s = 0; s < 2; ++s) {
        qraw[2 * s] = *(const u32x2*)(qrow + 32 * s + quad * 4);
        qraw[2 * s + 1] = *(const u32x2*)(qrow + 32 * s + 16 + quad * 4);
        kraw[2 * s] = *(const u32x2*)(qrow + 256 + 32 * s + quad * 4);
        kraw[2 * s + 1] = *(const u32x2*)(qrow + 256 + 32 * s + 16 + quad * 4);
      }
#pragma unroll
      for (int s = 0; s < 2; ++s) {
        vraw[2 * s] = *(const u32x2*)(qrow + 512 + 32 * s + quad * 4);
        vraw[2 * s + 1] = *(const u32x2*)(qrow + 512 + 32 * s + 16 + quad * 4);
      }
      braw = SM[(size_t)rl * 48]; graw = SM[(size_t)rl * 48 + 8];
    };
#pragma unroll 1
    for (int half = 0; half < 2; ++half) {
      const int nbeg = half * (N >> 1), nend = nbeg + (N >> 1);
      load_step(nbeg);
      asm volatile("" ::: "memory");
#pragma unroll 1
      for (int n = nbeg; n < nend; ++n) {
        bf16x8 qn[2], kn[2];
#pragma unroll
        for (int s = 0; s < 2; ++s) {
          qn[s] = __builtin_bit_cast(bf16x8, (u32x4){qraw[2 * s].x, qraw[2 * s].y, qraw[2 * s + 1].x, qraw[2 * s + 1].y});
          kn[s] = __builtin_bit_cast(bf16x8, (u32x4){kraw[2 * s].x, kraw[2 * s].y, kraw[2 * s + 1].x, kraw[2 * s + 1].y});
        }
        bf16x8 vn[2];
#pragma unroll
        for (int s = 0; s < 2; ++s) vn[s] = __builtin_bit_cast(bf16x8, (u32x4){vraw[2 * s].x, vraw[2 * s].y, vraw[2 * s + 1].x, vraw[2 * s + 1].y});
        float cb = braw, cg = graw;
        load_step(n + 1 < nend ? n + 1 : n);
        asm volatile("" : "+v"(qn[0]), "+v"(qn[1]), "+v"(kn[0]), "+v"(kn[1]), "+v"(cb), "+v"(cg), "+v"(vn[0]), "+v"(vn[1]) :: "memory");
        f32x4 VC[4];
#pragma unroll
        for (int et = 0; et < 4; ++et) VC[et] = mfma16(vn[et >> 1], (et & 1) ? selO : selE, F4Z);
        const float beta_l = 1.f / (1.f + fexp(-cb));
        float b_l = -A * softplusf(cg + dtb);
#pragma unroll
        for (int o = 1; o < 16; o <<= 1) { float t = __shfl_up(b_l, o, 16); if (l15 >= o) b_l += t; }
        float bq[4], betaq[4];
#pragma unroll
        for (int j = 0; j < 4; ++j) { bq[j] = __shfl(b_l, quad * 4 + j); betaq[j] = __shfl(beta_l, quad * 4 + j); }
        const float blast = __shfl(b_l, 15);
        const float cd = fexp(blast);
        bf16x8 rup[4], rwp[4], kdp[4];
#pragma unroll
        for (int t = 0; t < 4; ++t) {
          f32x4 KC = mfma16(kn[t >> 1], (t & 1) ? selO : selE, F4Z);
          f32x4 ru, rw, kd;
#pragma unroll
          for (int j = 0; j < 4; ++j) {
            ru[j] = betaq[j] * VC[t][j];
            rw[j] = betaq[j] * fexp(bq[j]) * KC[j];
            kd[j] = KC[j] * fexp(blast - bq[j]);
          }
          rup[t] = pk4(ru); rwp[t] = pk4(rw); kdp[t] = pk4(kd);
        }
        f32x4 kk = mfma16(kn[0], kn[0], F4Z); kk = mfma16(kn[1], kn[1], kk);
        f32x4 kq = mfma16(kn[0], qn[0], F4Z); kq = mfma16(kn[1], qn[1], kq);
        f32x4 P1, Q1, Z, AT;
#pragma unroll
        for (int j = 0; j < 4; ++j) {
          int r = quad * 4 + j;
          float ef = fexp(fminf(b_l - bq[j], 0.f));
          P1[j] = (r > l15) ? betaq[j] * kk[j] * fexp(fminf(bq[j] - b_l, 0.f)) : 0.f;
          Q1[j] = (l15 > r) ? beta_l * kk[j] * ef : 0.f;
          Z[j] = (r == l15 ? 1.f : 0.f) - Q1[j];
          AT[j] = (l15 >= r) ? kq[j] * 0.125f * ef : 0.f;
        }
        const bf16x8 atp = pk4(AT);
        {
          bf16x8 p1 = pk4(P1), q1 = pk4(Q1);
          f32x4 P2 = mfma16(q1, p1, F4Z), Q2 = mfma16(p1, q1, F4Z);
          bf16x8 p2 = pk4(P2), q2 = pk4(Q2);
          Z = mfma16(p2, pk4(Z), Z);
          f32x4 P4 = mfma16(q2, p2, F4Z), Q4 = mfma16(p2, q2, F4Z);
          bf16x8 p4 = pk4(P4), q4 = pk4(Q4);
          Z = mfma16(p4, pk4(Z), Z);
          f32x4 P8 = mfma16(q4, p4, F4Z);
          Z = mfma16(pk4(P8), pk4(Z), Z);
        }
        const bf16x8 zp = pk4(Z);
        bf16x8 wn0, wn1;
        {
          f32x4 w0 = mfma16(rwp[0], zp, F4Z), w1 = mfma16(rwp[1], zp, F4Z);
          wn0 = pk8n(w0, w1);
          f32x4 w2 = mfma16(rwp[2], zp, F4Z), w3 = mfma16(rwp[3], zp, F4Z);
          wn1 = pk8n(w2, w3);
        }
        const float eq_l = 0.125f * fexp(b_l);
        const int slot = n & (SCAN_R - 1);
        ring_wait(done + slot, n - SCAN_R + 1);
        asm volatile("" ::: "memory");
        u32x4* sp = slots + slot * SCAN_SLOT_V4 * 64;
        const u32x4 zz = __builtin_bit_cast(u32x4, zp), aa = __builtin_bit_cast(u32x4, atp);
        const u32x4 r0 = __builtin_bit_cast(u32x4, rup[0]), r1 = __builtin_bit_cast(u32x4, rup[1]), r2 = __builtin_bit_cast(u32x4, rup[2]), r3 = __builtin_bit_cast(u32x4, rup[3]);
        const u32x4 k0 = __builtin_bit_cast(u32x4, kdp[0]), k1 = __builtin_bit_cast(u32x4, kdp[1]), k2 = __builtin_bit_cast(u32x4, kdp[2]), k3 = __builtin_bit_cast(u32x4, kdp[3]);
        sp[0 * 64] = (u32x4){zz.x, zz.y, aa.x, aa.y};
        sp[1 * 64] = (u32x4){r0.x, r0.y, r1.x, r1.y};
        sp[2 * 64] = (u32x4){r2.x, r2.y, r3.x, r3.y};
        sp[3 * 64] = __builtin_bit_cast(u32x4, wn0);
        sp[4 * 64] = __builtin_bit_cast(u32x4, wn1);
        sp[5 * 64] = __builtin_bit_cast(u32x4, qn[0]);
        sp[6 * 64] = __builtin_bit_cast(u32x4, qn[1]);
        sp[7 * 64] = (u32x4){k0.x, k0.y, k1.x, k1.y};
        sp[8 * 64] = (u32x4){k2.x, k2.y, k3.x, k3.y};
        sp[9 * 64] = (u32x4){__float_as_uint(eq_l), __float_as_uint(cd), 0u, 0u};
        asm volatile("s_waitcnt lgkmcnt(0)" ::: "memory");
        ready[slot] = n + 1;
        asm volatile("" ::: "memory");
      }
      __syncthreads();
    }
  } else {
    f32x4 St[4][4];
#pragma unroll
    for (int a2 = 0; a2 < 4; ++a2)
#pragma unroll
      for (int b2 = 0; b2 < 4; ++b2) St[a2][b2] = F4Z;
    u32x2 rpk[4] = {(u32x2){0u, 0u}, (u32x2){0u, 0u}, (u32x2){0u, 0u}, (u32x2){0u, 0u}};
    u16* prev_ptr = OUT + (size_t)(dir ? S - 1 - l15 : l15) * 256 + quad * 4;
#pragma unroll 1
    for (int half = 0; half < 2; ++half) {
      const int nbeg = half * (N >> 1), nend = nbeg + (N >> 1);
#pragma unroll 1
      for (int n = nbeg; n < nend; ++n) {
        const int t0 = dir ? S - 16 * (n + 1) : 16 * n;
#pragma unroll
        for (int et = 0; et < 4; ++et) *(u32x2*)(prev_ptr + et * 16) = rpk[et];
        {
          const size_t row = (size_t)(dir ? t0 + 15 - l15 : t0 + l15);
          prev_ptr = half == 0 ? OUT + row * 256 + quad * 4 : SLOT + row * 768 + quad * 4;
        }
        const int slot = n & (SCAN_R - 1);
        ring_wait(ready + slot, n + 1);
        asm volatile("" ::: "memory");
        const u32x4* sp = slots + slot * SCAN_SLOT_V4 * 64;
        const u32x4 m0 = sp[0 * 64], m1 = sp[1 * 64], m2 = sp[2 * 64], m3 = sp[3 * 64], m4 = sp[4 * 64], m5 = sp[5 * 64], m6 = sp[6 * 64], m7 = sp[7 * 64], m8 = sp[8 * 64], m9 = sp[9 * 64];
        asm volatile("s_waitcnt lgkmcnt(0)" ::: "memory");
        done[slot] = n + 1;
        asm volatile("" ::: "memory");
        const bf16x8 zp = __builtin_bit_cast(bf16x8, (u32x4){m0.x, m0.y, 0u, 0u}), atp = __builtin_bit_cast(bf16x8, (u32x4){m0.z, m0.w, 0u, 0u});
        bf16x8 rup[4], kdp[4];
        rup[0] = __builtin_bit_cast(bf16x8, (u32x4){m1.x, m1.y, 0u, 0u}); rup[1] = __builtin_bit_cast(bf16x8, (u32x4){m1.z, m1.w, 0u, 0u});
        rup[2] = __builtin_bit_cast(bf16x8, (u32x4){m2.x, m2.y, 0u, 0u}); rup[3] = __builtin_bit_cast(bf16x8, (u32x4){m2.z, m2.w, 0u, 0u});
        kdp[0] = __builtin_bit_cast(bf16x8, (u32x4){m7.x, m7.y, 0u, 0u}); kdp[1] = __builtin_bit_cast(bf16x8, (u32x4){m7.z, m7.w, 0u, 0u});
        kdp[2] = __builtin_bit_cast(bf16x8, (u32x4){m8.x, m8.y, 0u, 0u}); kdp[3] = __builtin_bit_cast(bf16x8, (u32x4){m8.z, m8.w, 0u, 0u});
        const bf16x8 wn0 = __builtin_bit_cast(bf16x8, m3), wn1 = __builtin_bit_cast(bf16x8, m4);
        const bf16x8 qn0 = __builtin_bit_cast(bf16x8, m5), qn1 = __builtin_bit_cast(bf16x8, m6);
        const float eq_l = __uint_as_float(m9.x), cd = __uint_as_float(m9.y);
        f32x4 O[4];
#pragma unroll
        for (int et = 0; et < 4; ++et) {
          const bf16x8 s01 = pk8(St[0][et], St[1][et]), s23 = pk8(St[2][et], St[3][et]);
          f32x4 vn = mfma16(zp, rup[et], F4Z);
          vn = mfma16(wn0, s01, vn);
          vn = mfma16(wn1, s23, vn);
          f32x4 t1 = mfma16(s01, qn0, F4Z);
          t1 = mfma16(s23, qn1, t1);
#pragma unroll
          for (int j = 0; j < 4; ++j) t1[j] *= eq_l;
          const bf16x8 vnp = pk4(vn);
          O[et] = mfma16(vnp, atp, t1);
#pragma unroll
          for (int dt = 0; dt < 4; ++dt) {
            f32x4 c = St[dt][et];
#pragma unroll
            for (int j = 0; j < 4; ++j) c[j] *= cd;
            St[dt][et] = mfma16(kdp[dt], vnp, c);
          }
        }
#pragma unroll
        for (int et = 0; et < 4; ++et) rpk[et] = (u32x2){pack2(O[et][0], O[et][1]), pack2(O[et][2], O[et][3])};
      }
#pragma unroll
      for (int et = 0; et < 4; ++et) *(u32x2*)(prev_ptr + et * 16) = rpk[et];
      __syncthreads();
    }
  }
  scan_combine(OUT, SLOT, 768, (const u16*)(p.ws + OFF_DGATE) + (size_t)sbase * 256 + h * 64, S, tid);
}

DI void gla_task(const Params& p, int L, int seq, int h, u16* smem) {
  const int tid = otid(), lane = tid & 63, wave = tid >> 6, l15 = lane & 15, quad = lane >> 4;
  const int dir = wave >> 1, role = wave & 1;
  const int sbase = seq_base(seq), S = seq_len(seq), N = S >> 4;
  u32x4* slots = (u32x4*)smem + (size_t)dir * SCAN_R * SCAN_SLOT_V4 * 64 + lane;
  volatile int* ready = (volatile int*)(smem + 20480) + dir * 8;
  volatile int* done = ready + 4;
  __syncthreads();
  if (tid < 16) ((volatile int*)(smem + 20480))[tid] = 0;
  __syncthreads();
  u16* OUT = (u16*)(p.ws + OFF_C2) + (size_t)sbase * 256 + h * 64;
  u16* SLOT = (u16*)(p.ws + OFF_LV) + (size_t)sbase * 256 + h * 64;
  if (role == 0) {
    const u16* LQ = (const u16*)(p.ws + OFF_LQ) + (size_t)sbase * 128 + h * 32;
    const u16* LK = (const u16*)(p.ws + OFF_LK) + (size_t)sbase * 128 + h * 32;
    const u16* LV = (const u16*)(p.ws + OFF_LV) + (size_t)sbase * 256 + h * 64;
    const float* SM = (const float*)(p.ws + OFF_SMALL) + (size_t)sbase * 48 + 16 + dir * 16;
    bf16x8 selE, selO, triB, wupB[2];
    float bias[2];
    {
      uint32_t w = ((l15 >> 2) == quad) ? (0x3F80u << ((l15 & 1) * 16)) : 0u;
      uint32_t w0 = (l15 & 2) ? 0u : w, w1 = (l15 & 2) ? w : 0u;
      selE = __builtin_bit_cast(bf16x8, (u32x4){w0, w1, 0u, 0u});
      selO = __builtin_bit_cast(bf16x8, (u32x4){0u, 0u, w0, w1});
      uint32_t t[2];
#pragma unroll
      for (int k = 0; k < 2; ++k) {
        uint32_t lo = (quad * 4 + 2 * k <= l15) ? 0x3F80u : 0u, hi = (quad * 4 + 2 * k + 1 <= l15) ? 0x3F80u : 0u;
        t[k] = lo | (hi << 16);
      }
      triB = __builtin_bit_cast(bf16x8, (u32x4){t[0], t[1], 0u, 0u});
#pragma unroll
      for (int tt = 0; tt < 2; ++tt) {
        const float* wsrc = p.gla_w_gate_up + (((size_t)L * 2 + dir) * 16 + quad * 4) * 128 + h * 32 + tt * 16 + l15;
        wupB[tt] = __builtin_bit_cast(bf16x8, (u32x4){pack2(wsrc[0], wsrc[128]), pack2(wsrc[256], wsrc[384]), 0u, 0u});
        bias[tt] = p.gla_b_gate[((size_t)L * 2 + dir) * 128 + h * 32 + tt * 16 + l15];
      }
    }
    const int ca0 = dir ? 12 - quad * 4 : quad * 4;
    u32x2 qraw[2], kraw[2], vraw[4]; float4 lowraw;
    auto load_step = [&](int n) {
      int t0 = dir ? S - 16 * (n + 1) : 16 * n;
      int rl = dir ? t0 + 15 - l15 : t0 + l15;
      qraw[0] = *(const u32x2*)(LQ + (size_t)rl * 128 + quad * 4);
      qraw[1] = *(const u32x2*)(LQ + (size_t)rl * 128 + 16 + quad * 4);
      kraw[0] = *(const u32x2*)(LK + (size_t)rl * 128 + quad * 4);
      kraw[1] = *(const u32x2*)(LK + (size_t)rl * 128 + 16 + quad * 4);
#pragma unroll
      for (int s = 0; s < 2; ++s) {
        vraw[2 * s] = *(const u32x2*)(LV + (size_t)rl * 256 + 32 * s + quad * 4);
        vraw[2 * s + 1] = *(const u32x2*)(LV + (size_t)rl * 256 + 32 * s + 16 + quad * 4);
      }
      lowraw = *(const float4*)(SM + (size_t)rl * 48 + quad * 4);
    };
#pragma unroll 1
    for (int half = 0; half < 2; ++half) {
      const int nbeg = half * (N >> 1), nend = nbeg + (N >> 1);
      load_step(nbeg);
      asm volatile("" ::: "memory");
#pragma unroll 1
      for (int n = nbeg; n < nend; ++n) {
        bf16x8 qn = __builtin_bit_cast(bf16x8, (u32x4){qraw[0].x, qraw[0].y, qraw[1].x, qraw[1].y});
        bf16x8 kn = __builtin_bit_cast(bf16x8, (u32x4){kraw[0].x, kraw[0].y, kraw[1].x, kraw[1].y});
        bf16x8 vn[2];
#pragma unroll
        for (int s = 0; s < 2; ++s) vn[s] = __builtin_bit_cast(bf16x8, (u32x4){vraw[2 * s].x, vraw[2 * s].y, vraw[2 * s + 1].x, vraw[2 * s + 1].y});
        bf16x8 lowA = __builtin_bit_cast(bf16x8, (u32x4){pack2(lowraw.x, lowraw.y), pack2(lowraw.z, lowraw.w), 0u, 0u});
        load_step(n + 1 < nend ? n + 1 : n);
        asm volatile("" : "+v"(qn), "+v"(kn), "+v"(lowA), "+v"(vn[0]), "+v"(vn[1]) :: "memory");
        f32x4 VC[4];
#pragma unroll
        for (int et = 0; et < 4; ++et) VC[et] = mfma16(vn[et >> 1], (et & 1) ? selO : selE, F4Z);
        f32x4 bC[2], bN[2];
#pragma unroll
        for (int t = 0; t < 2; ++t) {
          f32x4 g = mfma16(lowA, wupB[t], F4Z);
          f32x4 ghi, glo;
#pragma unroll
          for (int j = 0; j < 4; ++j) {
            g[j] = logsigmoidf(g[j] + bias[t]) * (1.f / 16.f);
            ghi[j] = bf2f(f2bf(g[j])); glo[j] = g[j] - ghi[j];
          }
          bN[t] = mfma16(pk4(ghi), triB, F4Z);
          bN[t] = mfma16(pk4(glo), triB, bN[t]);
          float p0 = g[0], p1 = p0 + g[1], p2 = p1 + g[2], p3 = p2 + g[3];
          float off = 0.f;
          float s1 = __shfl_up(p3, 16), s2 = __shfl_up(p3, 32), s3 = __shfl_up(p3, 48);
          if (quad >= 1) off += s1;
          if (quad >= 2) off += s2;
          if (quad >= 3) off += s3;
          bC[t] = (f32x4){p0 + off, p1 + off, p2 + off, p3 + off};
        }
        bf16x8 qe, ke;
        {
          u32x4 qu = __builtin_bit_cast(u32x4, qn), ku = __builtin_bit_cast(u32x4, kn);
          u32x4 qo, ko;
#pragma unroll
          for (int w = 0; w < 4; ++w) {
            float b0 = bN[w >> 1][(w & 1) * 2], b1 = bN[w >> 1][(w & 1) * 2 + 1];
            qo[w] = pack2(bf2f(qu[w] & 0xffff) * 0.17677669529663687f * fexp(b0), bf2f(qu[w] >> 16) * 0.17677669529663687f * fexp(b1));
            ko[w] = pack2(bf2f(ku[w] & 0xffff) * fexp(-b0), bf2f(ku[w] >> 16) * fexp(-b1));
          }
          qe = __builtin_bit_cast(bf16x8, qo); ke = __builtin_bit_cast(bf16x8, ko);
        }
        f32x4 AT = mfma16(ke, qe, F4Z);
#pragma unroll
        for (int j = 0; j < 4; ++j) AT[j] = (l15 >= quad * 4 + j) ? AT[j] : 0.f;
        const u32x4 aa = __builtin_bit_cast(u32x4, pk4(AT));
        f32x4 KC[2];
        KC[0] = mfma16(kn, selE, F4Z); KC[1] = mfma16(kn, selO, F4Z);
        u32x4 kdu[2]; f32x4 cdq[2];
#pragma unroll
        for (int dt = 0; dt < 2; ++dt) {
          const float blC = __shfl(bC[dt][3], 48 + l15);
          f32x4 kd;
#pragma unroll
          for (int j = 0; j < 4; ++j) {
            kd[j] = KC[dt][j] * fexp(blC - bC[dt][j]);
            cdq[dt][j] = fexp(__shfl(bN[dt][j], quad * 16 + 15));
          }
          kdu[dt] = __builtin_bit_cast(u32x4, pk4(kd));
        }
        u32x4 vcu[4];
#pragma unroll
        for (int et = 0; et < 4; ++et) vcu[et] = __builtin_bit_cast(u32x4, pk4(VC[et]));
        const int slot = n & (SCAN_R - 1);
        ring_wait(done + slot, n - SCAN_R + 1);
        asm volatile("" ::: "memory");
        u32x4* sp = slots + slot * SCAN_SLOT_V4 * 64;
        sp[0 * 64] = __builtin_bit_cast(u32x4, qe);
        sp[1 * 64] = (u32x4){aa.x, aa.y, kdu[0].x, kdu[0].y};
        sp[2 * 64] = (u32x4){kdu[1].x, kdu[1].y, vcu[0].x, vcu[0].y};
        sp[3 * 64] = (u32x4){vcu[1].x, vcu[1].y, vcu[2].x, vcu[2].y};
        sp[4 * 64] = (u32x4){vcu[3].x, vcu[3].y, 0u, 0u};
        sp[5 * 64] = __builtin_bit_cast(u32x4, cdq[0]);
        sp[6 * 64] = __builtin_bit_cast(u32x4, cdq[1]);
        asm volatile("s_waitcnt lgkmcnt(0)" ::: "memory");
        ready[slot] = n + 1;
        asm volatile("" ::: "memory");
      }
      __syncthreads();
    }
  } else {
    f32x4 St[2][4];
#pragma unroll
    for (int a2 = 0; a2 < 2; ++a2)
#pragma unroll
      for (int b2 = 0; b2 < 4; ++b2) St[a2][b2] = F4Z;
    u32x2 rpk[4] = {(u32x2){0u, 0u}, (u32x2){0u, 0u}, (u32x2){0u, 0u}, (u32x2){0u, 0u}};
    u16* prev_ptr = OUT + (size_t)(dir ? S - 1 - l15 : l15) * 256 + quad * 4;
#pragma unroll 1
    for (int half = 0; half < 2; ++half) {
      const int nbeg = half * (N >> 1), nend = nbeg + (N >> 1);
#pragma unroll 1
      for (int n = nbeg; n < nend; ++n) {
        const int t0 = dir ? S - 16 * (n + 1) : 16 * n;
#pragma unroll
        for (int et = 0; et < 4; ++et) *(u32x2*)(prev_ptr + et * 16) = rpk[et];
        {
          const size_t row = (size_t)(dir ? t0 + 15 - l15 : t0 + l15);
          prev_ptr = (half == 0 ? OUT : SLOT) + row * 256 + quad * 4;
        }
        const int slot = n & (SCAN_R - 1);
        ring_wait(ready + slot, n + 1);
        asm volatile("" ::: "memory");
        const u32x4* sp = slots + slot * SCAN_SLOT_V4 * 64;
        const u32x4 m0 = sp[0 * 64], m1 = sp[1 * 64], m2 = sp[2 * 64], m3 = sp[3 * 64], m4 = sp[4 * 64], m5 = sp[5 * 64], m6 = sp[6 * 64];
        asm volatile("s_waitcnt lgkmcnt(0)" ::: "memory");
        done[slot] = n + 1;
        asm volatile("" ::: "memory");
        const bf16x8 qe = __builtin_bit_cast(bf16x8, m0);
        const bf16x8 atp = __builtin_bit_cast(bf16x8, (u32x4){m1.x, m1.y, 0u, 0u});
        bf16x8 kdp[2], vcp[4];
        kdp[0] = __builtin_bit_cast(bf16x8, (u32x4){m1.z, m1.w, 0u, 0u}); kdp[1] = __builtin_bit_cast(bf16x8, (u32x4){m2.x, m2.y, 0u, 0u});
        vcp[0] = __builtin_bit_cast(bf16x8, (u32x4){m2.z, m2.w, 0u, 0u}); vcp[1] = __builtin_bit_cast(bf16x8, (u32x4){m3.x, m3.y, 0u, 0u});
        vcp[2] = __builtin_bit_cast(bf16x8, (u32x4){m3.z, m3.w, 0u, 0u}); vcp[3] = __builtin_bit_cast(bf16x8, (u32x4){m4.x, m4.y, 0u, 0u});
        f32x4 cdq[2]; cdq[0] = __builtin_bit_cast(f32x4, m5); cdq[1] = __builtin_bit_cast(f32x4, m6);
        f32x4 O[4];
#pragma unroll
        for (int et = 0; et < 4; ++et) {
          O[et] = mfma16(vcp[et], atp, F4Z);
          O[et] = mfma16(pk8(St[0][et], St[1][et]), qe, O[et]);
        }
#pragma unroll
        for (int dt = 0; dt < 2; ++dt)
#pragma unroll
          for (int et = 0; et < 4; ++et) {
            f32x4 c = St[dt][et];
#pragma unroll
            for (int j = 0; j < 4; ++j) c[j] *= cdq[dt][j];
            St[dt][et] = mfma16(kdp[dt], vcp[et], c);
          }
#pragma unroll
        for (int et = 0; et < 4; ++et) rpk[et] = (u32x2){pack2(O[et][0], O[et][1]), pack2(O[et][2], O[et][3])};
      }
#pragma unroll
      for (int et = 0; et < 4; ++et) *(u32x2*)(prev_ptr + et * 16) = rpk[et];
      __syncthreads();
    }
  }
  scan_combine(OUT, SLOT, 256, (const u16*)(p.ws + OFF_LGATE) + (size_t)sbase * 256 + h * 64, S, tid);
}

DI void scan_block(const Params& p, int L, int task, u16* smem) {
  __builtin_amdgcn_s_setprio(3);
  if (task < 96) dn_task(p, L, task >> 2, task & 3, smem); else gla_task(p, L, (task - 96) >> 2, task & 3, smem);
  __builtin_amdgcn_s_setprio(0);
}

#define N_SCAN_TASKS 192
#define N_MIX_TASKS (192 + 2048 + 2048)
DI void mix_task(const Params& p, int L, int task, u16* smem) {
  if (task < N_SCAN_TASKS) {
    scan_block(p, L, task, smem);
    return;
  }
  int u = task - N_SCAN_TASKS;
  if (u < 2048) {
    int seq, h, qb;
    if (u < 1024) { seq = u >> 7; h = (u >> 5) & 3; qb = u & 31; }
    else { u -= 1024; seq = 8 + (u >> 6); h = (u >> 4) & 3; qb = u & 15; }
    int sbase = seq_base(seq), S = seq_len(seq);
    int kvh = h >> 1;
    u16* Qp = (u16*)(p.ws + OFF_C0) + (size_t)(sbase + qb * 128) * 256 + h * 64;
    const u16* Kp = (const u16*)(p.ws + OFF_AK) + (size_t)sbase * 128 + kvh * 64;
    const u16* VTp = (const u16*)(p.ws + OFF_AVT) + (size_t)sbase * 128 + (size_t)kvh * 64 * S;
    const u16* Gp = (const u16*)(p.ws + OFF_AGATE) + (size_t)(sbase + qb * 128) * 256 + h * 64;
#ifndef NO_ATT
    attn_block(Qp, Kp, 128, VTp, S, Gp, smem);
#endif
  } else {
    u -= 2048;
    int qbg = u >> 2, h = u & 3;
    int tok0 = qbg * 128;
    int seq = seq_of_token(tok0);
    u16* Qp = (u16*)(p.ws + OFF_C3) + (size_t)tok0 * 256 + h * 64;
    const u16* Kp = (const u16*)(p.ws + OFF_KM) + (size_t)seq * 256 * 256 + h * 64;
    const u16* VTp = (const u16*)(p.ws + OFF_VMT) + ((size_t)seq * 4 + h) * 64 * 256;
    const u16* Gp = (const u16*)(p.ws + OFF_MGATE) + (size_t)tok0 * 256 + h * 64;
#ifndef NO_ATT
    attn_block(Qp, Kp, 256, VTp, 256, Gp, smem);
#endif
  }
}

DI void phase_final(const Params& p, int gtid, int gthreads) {
  int wid = gtid >> 6, nw = gthreads >> 6, lane = gtid & 63;
  const float* HF = (const float*)(p.ws + OFF_HFINAL);
  const float* SUMSQ = (const float*)(p.ws + OFF_SUMSQ);
  float4 g[4];
#pragma unroll
  for (int i = 0; i < 4; ++i) g[i] = *(const float4*)(p.final_norm_g + i * 256 + lane * 4);
  for (int t0 = wid; t0 < T_TOK; t0 += 2 * nw) {
    float4 v[2][4]; float ssq[2];
#pragma unroll
    for (int u = 0; u < 2; ++u) {
      const int t = t0 + u * nw < T_TOK ? t0 + u * nw : t0;
      ssq[u] = lane < 16 ? SUMSQ[(size_t)t * 16 + lane] : 0.f;
#pragma unroll
      for (int i = 0; i < 4; ++i) v[u][i] = *(const float4*)(HF + (size_t)t * 1024 + i * 256 + lane * 4);
    }
#pragma unroll
    for (int u = 0; u < 2; ++u) {
      const int t = t0 + u * nw;
      if (t < T_TOK) {
        const float r = rsqrtf(wave_sum(ssq[u]) * (1.f / 1024.f) + EPSF);
#pragma unroll
        for (int i = 0; i < 4; ++i) {
          const float4 a = v[u][i];
          *(float4*)(p.out + (size_t)t * 1024 + i * 256 + lane * 4) = make_float4(a.x * r * g[i].x, a.y * r * g[i].y, a.z * r * g[i].z, a.w * r * g[i].w);
        }
      }
    }
  }
}

#define XB_TMO      128
#define XB_XCNT(j)  (256  + 64 * (j))
#define XB_XSUB(j)  (1280 + 64 * (j))
#define XB_XGEN(j)  (2304 + 64 * (j))
#define XB_TOP      3328
#define XB_TOPGEN   3392
#define XCD_BAR_WORDS 3456
#define XB_SPIN_CAP (1u << 18)
#define LAS __attribute__((address_space(3)))

__device__ __forceinline__ unsigned xb_ld(unsigned* p)              { return __hip_atomic_load(p, __ATOMIC_RELAXED, __HIP_MEMORY_SCOPE_AGENT); }
__device__ __forceinline__ unsigned xb_add(unsigned* p, unsigned v) { return __hip_atomic_fetch_add(p, v, __ATOMIC_RELAXED, __HIP_MEMORY_SCOPE_AGENT); }
__device__ __forceinline__ unsigned xb_xcc_id() { return (unsigned)__builtin_amdgcn_s_getreg((3 << 11) | 20) & 0xFu; }
#define XB_SPIN(cond, bar) do { unsigned _sp = 0; while (cond) { __builtin_amdgcn_s_sleep(1); \
    if ((++_sp & 255u) == 0u) { if (xb_ld(&(bar)[XB_TMO])) break; if (_sp > XB_SPIN_CAP) { atomicAdd(&(bar)[XB_TMO], 1u); break; } } } } while (0)

struct XcdBarrier {
    unsigned* bar; unsigned x;
    volatile LAS unsigned* st;
};

__device__ __forceinline__ XcdBarrier xcd_barrier_post(unsigned* bar, volatile LAS unsigned* st) {
    XcdBarrier b; b.bar = bar; b.x = xb_xcc_id(); b.st = st;
    if (threadIdx.x == 0) (void)xb_add(&bar[XB_XCNT(b.x)], 1u);
    return b;
}
__device__ __forceinline__ void xcd_barrier_complete(unsigned* bar, unsigned x, unsigned& nloc, unsigned& nx) {
    const unsigned G = gridDim.x * gridDim.y * gridDim.z;
    unsigned sum, cnt, mine, sp = 0u;
    for (;;) {
        sum = 0u; cnt = 0u; mine = 0u;
#pragma unroll
        for (unsigned j = 0; j < 16; ++j) { const unsigned c = xb_ld(&bar[XB_XCNT(j)]); sum += c; cnt += (c > 0u) ? 1u : 0u; mine = (j == x) ? c : mine; }
        if (sum == G) break;
        __builtin_amdgcn_s_sleep(1);
        if ((++sp & 255u) == 0u) { if (xb_ld(&bar[XB_TMO])) break; if (sp > XB_SPIN_CAP) { atomicAdd(&bar[XB_TMO], 1u); break; } }
    }
    nloc = mine > 0u ? mine : 1u; nx = cnt > 0u ? cnt : 1u;
}

__device__ __forceinline__ void xcd_barrier(const XcdBarrier& b) {
    asm volatile("s_waitcnt vmcnt(0)" ::: "memory");
    __syncthreads();
    if (threadIdx.x == 0) {
        unsigned* bar = b.bar;
        __builtin_amdgcn_s_waitcnt(0);
        unsigned nloc = b.st[0], nx = b.st[1];
        if (nloc == 0u) { xcd_barrier_complete(bar, b.x, nloc, nx); b.st[0] = nloc; b.st[1] = nx; }
        const unsigned old = xb_add(&bar[XB_XSUB(b.x)], 1u);
        const unsigned gen = old / nloc;
        if (old + 1u == (gen + 1u) * nloc) {
            __builtin_amdgcn_fence(__ATOMIC_RELEASE, "agent");
            asm volatile("s_waitcnt vmcnt(0)" ::: "memory");
            const unsigned og = xb_add(&bar[XB_TOP], 1u);
            const unsigned tg = og / nx;
            if (og + 1u == (tg + 1u) * nx) xb_add(&bar[XB_TOPGEN], 1u);
            else XB_SPIN(xb_ld(&bar[XB_TOPGEN]) == tg, bar);
            __builtin_amdgcn_fence(__ATOMIC_ACQUIRE, "agent");
            xb_add(&bar[XB_XGEN(b.x)], 1u);
            asm volatile("s_waitcnt vmcnt(0)" ::: "memory");
        } else {
            XB_SPIN(xb_ld(&bar[XB_XGEN(b.x)]) == gen, bar);
            __builtin_amdgcn_fence(__ATOMIC_ACQUIRE, "agent");
            asm volatile("s_waitcnt vmcnt(0)" ::: "memory");
        }
    }
    __syncthreads();
}


#define N_PHASES 18
#ifndef LB_MIN
#define LB_MIN 2
#endif
#define SMEM_BYTES (384 * LDS_STRIDE * 2 + 1024)

template <bool COOP>
__global__ void __launch_bounds__(256, LB_MIN) mega(Params p, int ph_lo, int ph_hi) {
  extern __shared__ __attribute__((aligned(16))) unsigned char smem_raw[];
  __shared__ int s_task;
  __shared__ int s_elig;
  __shared__ uint4 xb_words;
  u16* smem = (u16*)smem_raw;
  const int gthreads = gridDim.x * 256;
  XcdBarrier xb;
  if (COOP) {
    if (threadIdx.x == 0) xb_words = make_uint4(0u, 0u, 0u, 0u);
    __syncthreads();
    xb = xcd_barrier_post((unsigned*)(p.ws + OFF_XBAR), (volatile LAS unsigned*)&xb_words);
  }
  for (int ph = ph_lo; ph < ph_hi; ++ph) {
    const int gtid = blockIdx.x * 256 + otid();
    if (ph == 0) {
#ifndef NO_P0
      phase_prep(p, gtid, gthreads);
#endif
    } else if (ph == N_PHASES - 1) {
#ifndef NO_FIN
      phase_final(p, gtid, gthreads);
#endif
    } else {
      int L = (ph - 1) / 4, sub = (ph - 1) % 4;
      if (sub == 0) {
        for (int t = blockIdx.x; t < 13 * 512 + 96; t += gridDim.x) {
#ifndef NO_G1
          if (t < 13 * 512) g1_tile(p, L, t, smem);
#endif
#ifndef NO_G3
          if (t >= 13 * 512) g3_tile(p, L, t - 13 * 512, smem);
#endif
        }
      } else if (sub == 1) {
#ifndef NO_PREP
        for (int t = blockIdx.x; t < 2048; t += gridDim.x) prep_task(p, L, t, smem);
#endif
      } else if (sub == 2) {
        int* cnt_scan = (int*)(p.ws + OFF_CNT) + L;
        int* cnt_att = (int*)(p.ws + OFF_CNT) + 4 + L;
        __syncthreads();
        if (threadIdx.x == 0) {
          unsigned xcc = __builtin_amdgcn_s_getreg((3 << 11) | (0 << 6) | 20);
          unsigned hw = __builtin_amdgcn_s_getreg((15 << 11) | (0 << 6) | 4);
          unsigned cu = (hw >> 8) & 0xf, sh = (hw >> 12) & 1, se = (hw >> 13) & 7;
          unsigned cuid = (((xcc & 15) * 8 + se) * 2 + sh) * 16 + cu;
          s_elig = atomicCAS((int*)(p.ws + OFF_CUFLAG) + L * 4096 + cuid, 0, 1) == 0 ? 1 : 0;
        }
        while (true) {
          __syncthreads();
          if (threadIdx.x == 0) {
            int task = -1;
            if (s_elig) { int t = atomicAdd(cnt_scan, 1); if (t < N_SCAN_TASKS) task = t; else s_elig = 0; }
            if (task < 0) { int t = atomicAdd(cnt_att, 1); task = t < (N_MIX_TASKS - N_SCAN_TASKS) ? N_SCAN_TASKS + t : N_MIX_TASKS; }
            s_task = task;
          }
          __syncthreads();
          int task = s_task;
          if (task >= N_MIX_TASKS) break;
          mix_task(p, L, task, smem);
        }
      } else {
#ifndef NO_G2
        for (int t = blockIdx.x; t < 2048; t += gridDim.x) g2_tile(p, L, t, smem);
#endif
      }
    }
    if (COOP && ph + 1 < ph_hi) {
      if (ph == 0) cg::this_grid().sync();
      else xcd_barrier(xb);
    }
  }
}

extern "C" void kernel_launch(void* const* d_in, const int* in_sizes, int n_in, void* d_out, int out_size,
                              void* d_ws, size_t ws_size, hipStream_t stream) {
  if (ws_size < WS_NEED) { fprintf(stderr, "ws too small: %zu < %zu\n", ws_size, (size_t)WS_NEED); return; }
  Params p{};
  const float** pp = (const float**)&p;
  for (int i = 0; i < 19; ++i) pp[i] = (const float*)d_in[i];
  p.out = (float*)d_out; p.ws = (unsigned char*)d_ws;
  (void)hipMemsetAsync((unsigned char*)d_ws + OFF_CNT, 0, 256 + 4 * 4096 * 4 + 3456 * 4, stream);
  static int grid_blocks = 0;
  if (!grid_blocks) {
    int dev = 0, cus = 0, per_cu = 0;
    (void)hipGetDevice(&dev);
    (void)hipDeviceGetAttribute(&cus, hipDeviceAttributeMultiprocessorCount, dev);
    (void)hipFuncSetAttribute((const void*)mega<true>, hipFuncAttributeMaxDynamicSharedMemorySize, SMEM_BYTES);
    (void)hipOccupancyMaxActiveBlocksPerMultiprocessor(&per_cu, mega<true>, 256, SMEM_BYTES);
    if (per_cu < 1) per_cu = 1;
    if (per_cu > 2) per_cu = 2;
    grid_blocks = cus * per_cu;
  }
  int ph_lo = 0, ph_hi = N_PHASES;
  void* args[] = {&p, &ph_lo, &ph_hi};
  hipError_t e = hipLaunchCooperativeKernel((void*)mega<true>, dim3(grid_blocks), dim3(256), args, SMEM_BYTES, stream);
  if (e != hipSuccess) fprintf(stderr, "cooperative launch failed: %s (grid %d)\n", hipGetErrorString(e), grid_blocks);
}
```

```cpp
#include <hip/hip_runtime.h>
#include <hip/hip_cooperative_groups.h>
#include <stdint.h>
#include <stdio.h>
namespace cg = cooperative_groups;

typedef __attribute__((ext_vector_type(8))) short bf16x8;
typedef __attribute__((ext_vector_type(4))) float f32x4;
typedef unsigned short u16;
typedef __attribute__((ext_vector_type(4))) unsigned int u32x4;
typedef __attribute__((ext_vector_type(2))) unsigned int u32x2;

#define DI __device__ __forceinline__
#define T_TOK 65536
#define DM 1024
#define NPAD 3200
#define NIN 3120
#define EPSF 1e-6f
#define LDS_STRIDE 72

static constexpr size_t SZ_C = (size_t)T_TOK * 256 * 2;
static constexpr size_t OFF_C0 = 0;
static constexpr size_t OFF_C1 = OFF_C0 + SZ_C;
static constexpr size_t OFF_C2 = OFF_C1 + SZ_C;
static constexpr size_t OFF_C3 = OFF_C2 + SZ_C;
static constexpr size_t OFF_AK = OFF_C3 + SZ_C;
static constexpr size_t OFF_AVT = OFF_AK + SZ_C / 2;
static constexpr size_t OFF_AGATE = OFF_AVT + SZ_C / 2;
static constexpr size_t OFF_DGATE = OFF_AGATE + SZ_C;
static constexpr size_t OFF_LGATE = OFF_DGATE + SZ_C;
static constexpr size_t OFF_MGATE = OFF_LGATE + SZ_C;
static constexpr size_t OFF_DQKV = OFF_MGATE + SZ_C;
static constexpr size_t OFF_LQ = OFF_DQKV + 3 * SZ_C;
static constexpr size_t OFF_LK = OFF_LQ + SZ_C / 2;
static constexpr size_t OFF_LV = OFF_LK + SZ_C / 2;
static constexpr size_t OFF_HFINAL = OFF_AK;
static constexpr size_t OFF_SMALL = OFF_LV + SZ_C;
static constexpr size_t OFF_SUMSQ = OFF_SMALL + (size_t)T_TOK * 48 * 4;
static constexpr size_t OFF_WIN = OFF_SUMSQ + (size_t)T_TOK * 16 * 4;
static constexpr size_t OFF_WOUT = OFF_WIN + (size_t)4 * NPAD * 1024 * 2;
static constexpr size_t OFF_WMKV = OFF_WOUT + (size_t)4 * 1024 * 1024 * 2;
static constexpr size_t OFF_KM = OFF_WMKV + (size_t)4 * 512 * 1024 * 2;
static constexpr size_t OFF_VMT = OFF_KM + (size_t)6144 * 256 * 2;
static constexpr size_t OFF_MEMRSTD = OFF_VMT + (size_t)6144 * 256 * 2;
static constexpr size_t OFF_ROPE = OFF_MEMRSTD + 6144 * 4;
static constexpr size_t OFF_HALO = OFF_ROPE + 2 * 64 * 16 * 4;
static constexpr size_t OFF_CNT = OFF_HALO + (size_t)512 * 2 * 768 * 2;
static constexpr size_t OFF_CUFLAG = OFF_CNT + 256;
static constexpr size_t OFF_XBAR = OFF_CUFLAG + 4 * 4096 * 4;
static constexpr size_t WS_NEED = OFF_XBAR + 3456 * 4;
static_assert(OFF_HFINAL + (size_t)T_TOK * 1024 * 4 <= OFF_SMALL, "hfinal alias");
static_assert(WS_NEED <= (size_t)536870912, "ws budget");

struct Params {
  const float* x_prompt; const float* x_sample; const float* mem_prompt; const float* mem_sample;
  const float* norm_g; const float* w_in; const float* att_q_norm_g; const float* att_k_norm_g;
  const float* gdn_conv_w; const float* gdn_a_log; const float* gdn_dt_bias; const float* gdn_out_norm_g;
  const float* gla_w_gate_up; const float* gla_b_gate; const float* gla_out_norm_g; const float* mem_norm_g;
  const float* w_mem_kv; const float* w_out; const float* final_norm_g;
  float* out; unsigned char* ws;
};

DI u16 f2bf(float f) { uint32_t u = __float_as_uint(f); u += 0x7fffu + ((u >> 16) & 1u); return (u16)(u >> 16); }
DI float bf2f(u16 h) { return __uint_as_float(((uint32_t)h) << 16); }
typedef __attribute__((ext_vector_type(2))) float f32x2_t;
typedef __attribute__((ext_vector_type(2))) __bf16 bf16x2_t;
DI uint32_t pack2(float a, float b) { f32x2_t v = {a, b}; return __builtin_bit_cast(uint32_t, __builtin_convertvector(v, bf16x2_t)); }
DI float fast_exp2(float x) { float r; asm("v_exp_f32 %0, %1\n\ts_nop 1" : "=v"(r) : "v"(x)); return r; }
DI float fast_log2(float x) { float r; asm("v_log_f32 %0, %1\n\ts_nop 1" : "=v"(r) : "v"(x)); return r; }
DI float fexp(float x) { return fast_exp2(x * 1.4426950408889634f); }
DI float flog(float x) { return fast_log2(x) * 0.6931471805599453f; }
DI float siluf(float x) { return x / (1.f + fexp(-x)); }
DI float wave_sum(float v) {
#pragma unroll
  for (int o = 32; o >= 1; o >>= 1) v += __shfl_xor(v, o);
  return v;
}
DI int seq_of_token(int t) { return t < 32768 ? (t >> 12) : 8 + ((t - 32768) >> 11); }
DI int seq_base(int s) { return s < 8 ? s * 4096 : 32768 + (s - 8) * 2048; }
DI int seq_len(int s) { return s < 8 ? 4096 : 2048; }
DI int otid() { int t = threadIdx.x; asm volatile("" : "+v"(t)); return t; }
DI f32x4 mfma16(bf16x8 a, bf16x8 b, f32x4 c) { return __builtin_amdgcn_mfma_f32_16x16x32_bf16(a, b, c, 0, 0, 0); }

DI int win_orig_col(int n) {
  if (n < 768) return n;
  if (n < 1536) return n;
  if (n < 1792) return n - 1536 + 1552;
  if (n < 1920) return n - 1792 + 1808;
  if (n < 2048) return n - 1920 + 1936;
  if (n < 2304) return n - 2048 + 2064;
  if (n < 2560) return n - 2304 + 2352;
  if (n < 2816) return n - 2560 + 2608;
  if (n < 3072) return n - 2816 + 2864;
  if (n < 3080) return n - 3072 + 1536;
  if (n < 3088) return n - 3080 + 1544;
  return n - 3088 + 2320;
}

DI void phase_prep(const Params& p, int gtid, int gthreads) {
  u16* WIN = (u16*)(p.ws + OFF_WIN);
  u16* WOUT = (u16*)(p.ws + OFF_WOUT);
  u16* WMKV = (u16*)(p.ws + OFF_WMKV);
  for (int it = gtid; it < 4 * 128 * NPAD; it += gthreads) {
    int n = it % NPAD; int r = it / NPAD; int kc = r & 127; int L = r >> 7;
    uint32_t o[4] = {0, 0, 0, 0};
    if (n < NIN) {
      int oc = win_orig_col(n);
      const float* src = p.w_in + ((size_t)L * 1024 + kc * 8) * NIN + oc;
      const float* g = p.norm_g + L * 1024 + kc * 8;
      float v[8];
#pragma unroll
      for (int j = 0; j < 8; ++j) v[j] = src[(size_t)j * NIN] * g[j];
#pragma unroll
      for (int j = 0; j < 4; ++j) o[j] = pack2(v[2 * j], v[2 * j + 1]);
    }
    *(uint4*)(WIN + ((size_t)L * NPAD + n) * 1024 + kc * 8) = make_uint4(o[0], o[1], o[2], o[3]);
  }
  for (int it = gtid; it < 4 * 128 * 1024; it += gthreads) {
    int n = it & 1023; int r = it >> 10; int kc = r & 127; int L = r >> 7;
    const float* src = p.w_out + ((size_t)L * 1024 + kc * 8) * 1024 + n;
    uint32_t o[4];
#pragma unroll
    for (int j = 0; j < 4; ++j) o[j] = pack2(src[(size_t)(2 * j) * 1024], src[(size_t)(2 * j + 1) * 1024]);
    *(uint4*)(WOUT + ((size_t)L * 1024 + n) * 1024 + kc * 8) = make_uint4(o[0], o[1], o[2], o[3]);
  }
  for (int it = gtid; it < 4 * 128 * 512; it += gthreads) {
    int n = it & 511; int r = it >> 9; int kc = r & 127; int L = r >> 7;
    const float* src = p.w_mem_kv + ((size_t)L * 1024 + kc * 8) * 512 + n;
    const float* g = p.mem_norm_g + L * 1024 + kc * 8;
    uint32_t o[4];
#pragma unroll
    for (int j = 0; j < 4; ++j) o[j] = pack2(src[(size_t)(2 * j) * 512] * g[2 * j], src[(size_t)(2 * j + 1) * 512] * g[2 * j + 1]);
    *(uint4*)(WMKV + ((size_t)L * 512 + n) * 1024 + kc * 8) = make_uint4(o[0], o[1], o[2], o[3]);
  }
  float* rope = (float*)(p.ws + OFF_ROPE);
  for (int it = gtid; it < 1024; it += gthreads) {
    int pos = it >> 4, i = it & 15;
    float inv = exp2f(-(float)i * (13.287712379549449f / 16.f));
    float a = (float)pos * inv;
    rope[it] = __cosf(a); rope[1024 + it] = __sinf(a);
  }
  int wid = gtid >> 6, nw = gthreads >> 6, lane = gtid & 63;
  u16* HI = (u16*)p.out; u16* LO = HI + (size_t)T_TOK * 1024;
  float* SUMSQ = (float*)(p.ws + OFF_SUMSQ);
  for (int t0 = wid; t0 < T_TOK; t0 += 2 * nw) {
    float4 v[2][4];
#pragma unroll
    for (int u = 0; u < 2; ++u) {
      const int t = t0 + u * nw < T_TOK ? t0 + u * nw : t0;
      const float* src = t < 32768 ? p.x_prompt + (size_t)t * 1024 : p.x_sample + (size_t)(t - 32768) * 1024;
#pragma unroll
      for (int i = 0; i < 4; ++i) v[u][i] = *(const float4*)(src + i * 256 + lane * 4);
    }
#pragma unroll
    for (int u = 0; u < 2; ++u) {
      const int t = t0 + u * nw;
      if (t < T_TOK) {
        float ss = 0.f;
#pragma unroll
        for (int i = 0; i < 4; ++i) {
          const float4 a = v[u][i];
          ss += a.x * a.x + a.y * a.y + a.z * a.z + a.w * a.w;
          *(uint2*)(HI + (size_t)t * 1024 + i * 256 + lane * 4) = make_uint2(pack2(a.x, a.y), pack2(a.z, a.w));
        }
        ss += __shfl_xor(ss, 1); ss += __shfl_xor(ss, 2);
        if ((lane & 3) == 0) SUMSQ[(size_t)t * 16 + (lane >> 2)] = ss;
      }
    }
  }
  float* MEMRSTD = (float*)(p.ws + OFF_MEMRSTD);
  for (int r = wid; r < 6144; r += nw) {
    const float* src = r < 2048 ? p.mem_prompt + (size_t)r * 1024 : p.mem_sample + (size_t)(r - 2048) * 1024;
    float ss = 0.f;
#pragma unroll
    for (int i = 0; i < 4; ++i) { float4 v = *(const float4*)(src + i * 256 + lane * 4); ss += v.x * v.x + v.y * v.y + v.z * v.z + v.w * v.w; }
    ss = wave_sum(ss);
    if (lane == 0) MEMRSTD[r] = rsqrtf(ss * (1.f / 1024.f) + EPSF);
  }
}

struct QSrc { const void* base; int ldq; const u16* c0; const u16* c1; const u16* c2; const u16* c3; };

#define QT 8
#define TM 256
template <int QMODE>
DI void gemm_load(u32x4 (&pr)[4], u32x4 (&qr)[8], const u16* W, const QSrc& q, int m0, int k0, int tid) {
  const int row0 = tid >> 3, kc = tid & 7;
  const u16* wp = W + (size_t)row0 * 1024 + k0 + kc * 8;
#pragma unroll
  for (int i = 0; i < 4; ++i) pr[i] = *(const u32x4*)(wp + (size_t)i * 32 * 1024);
  if (QMODE == 0) {
    const u16* qp = (const u16*)q.base + (size_t)(m0 + row0) * 1024 + k0 + kc * 8;
#pragma unroll
    for (int i = 0; i < 8; ++i) qr[i] = *(const u32x4*)(qp + (size_t)i * 32 * 1024);
  } else if (QMODE == 1) {
    const float* s = (const float*)q.base + (size_t)(m0 + row0) * 1024 + k0 + kc * 8;
#pragma unroll
    for (int i = 0; i < 8; ++i) {
      float4 a = *(const float4*)(s + (size_t)i * 32 * 1024), b = *(const float4*)(s + (size_t)i * 32 * 1024 + 4);
      qr[i] = (u32x4){pack2(a.x, a.y), pack2(a.z, a.w), pack2(b.x, b.y), pack2(b.z, b.w)};
    }
  } else {
    const int rg = k0 >> 8;
    const u16* cb = q.c0 + (size_t)rg * ((size_t)T_TOK * 256);
    const u16* s = cb + (size_t)(m0 + row0) * 256 + (k0 & 255) + kc * 8;
#pragma unroll
    for (int i = 0; i < 8; ++i) qr[i] = *(const u32x4*)(s + (size_t)i * 32 * 256);
  }
}

template <int QMODE>
DI void gemm_core(f32x4 (&acc)[4][QT], const u16* W  , const QSrc& q, int m0, u16* smem) {
  const int tid = otid(), lane = tid & 63, wave = tid >> 6;
  const int wn = wave & 1, wq = wave >> 1, l15 = lane & 15, quad = lane >> 4;
  u16* Ps = smem; u16* Qs = smem + 128 * LDS_STRIDE;
#pragma unroll
  for (int a = 0; a < 4; ++a)
#pragma unroll
    for (int b = 0; b < QT; ++b) acc[a][b] = (f32x4){0.f, 0.f, 0.f, 0.f};
  u32x4 pr[4], qr[8];
  gemm_load<QMODE>(pr, qr, W, q, m0, 0, tid);
#pragma unroll 1
  for (int kt = 0; kt < 16; ++kt) {
    __syncthreads();
    {
      u16* wb = Ps + (tid >> 3) * LDS_STRIDE + (tid & 7) * 8;
#pragma unroll
      for (int i = 0; i < 4; ++i) *(u32x4*)(wb + i * 32 * LDS_STRIDE) = pr[i];
#pragma unroll
      for (int i = 0; i < 8; ++i) *(u32x4*)(wb + (128 + i * 32) * LDS_STRIDE) = qr[i];
    }
    __syncthreads();
    if (kt + 1 < 16) gemm_load<QMODE>(pr, qr, W, q, m0, (kt + 1) * 64, tid);
#pragma unroll
    for (int ks = 0; ks < 2; ++ks) {
      bf16x8 pf[4];
#pragma unroll
      for (int i = 0; i < 4; ++i) pf[i] = *(const bf16x8*)(Ps + (wn * 64 + i * 16 + l15) * LDS_STRIDE + ks * 32 + quad * 8);
#pragma unroll
      for (int hb = 0; hb < 2; ++hb) {
        bf16x8 qf[4];
#pragma unroll
        for (int i = 0; i < 4; ++i) qf[i] = *(const bf16x8*)(Qs + (wq * 128 + (hb * 4 + i) * 16 + l15) * LDS_STRIDE + ks * 32 + quad * 8);
        __builtin_amdgcn_sched_barrier(0);
#pragma unroll
        for (int a = 0; a < 4; ++a)
#pragma unroll
          for (int b = 0; b < 4; ++b) acc[a][hb * 4 + b] = mfma16(pf[a], qf[b], acc[a][hb * 4 + b]);
        __builtin_amdgcn_sched_barrier(0);
      }
    }
  }
}

DI void g1_tile(const Params& p, int L, int tile, u16* smem) {
  int mt, nt;
  {
    const int xcd = tile & 7, lb = (tile & 511) >> 3, rnd = tile >> 9;
    const int j = lb + 64 * rnd;
    if (j >= 800) return;
    const int mg = j / 200, r = j % 200;
    int mi;
    if (r < 192) { const int rr = r & 63; mi = rr & 7; nt = (r >> 6) * 8 + (rr >> 3); } else { mi = r - 192; nt = 24; }
    mt = xcd * 32 + mg * 8 + mi;
  }
  const int m0 = mt * TM, n0 = nt * 128;
  const int tid = otid(), lane = tid & 63, wave = tid >> 6;
  const int wn = wave & 1, wq = wave >> 1, l15 = lane & 15, quad = lane >> 4;
  float* rstd_s = (float*)(smem + 384 * LDS_STRIDE);
  __syncthreads();
  {
    const float4* s = (const float4*)((const float*)(p.ws + OFF_SUMSQ) + (size_t)(m0 + tid) * 16);
    float4 a = s[0], b = s[1], c = s[2], d = s[3];
    float ss = a.x + a.y + a.z + a.w + b.x + b.y + b.z + b.w + c.x + c.y + c.z + c.w + d.x + d.y + d.z + d.w;
    rstd_s[tid] = rsqrtf(ss * (1.f / 1024.f) + EPSF);
  }
  f32x4 acc[4][QT];
  QSrc q; q.base = p.out; q.ldq = 1024;
  const u16* W = (const u16*)(p.ws + OFF_WIN) + ((size_t)L * NPAD + n0) * 1024;
  gemm_core<0>(acc, W, q, m0, smem);
  float rs[QT];
#pragma unroll
  for (int qt = 0; qt < QT; ++qt) rs[qt] = rstd_s[wq * 128 + qt * 16 + l15];
#pragma unroll
  for (int a = 0; a < 4; ++a)
#pragma unroll
    for (int b = 0; b < QT; ++b)
#pragma unroll
      for (int j = 0; j < 4; ++j) acc[a][b][j] *= rs[b];
  const int seq = seq_of_token(m0), sbase = seq_base(seq), slen = seq_len(seq);
  if (nt <= 2) {
    const float* g = (nt <= 1 ? p.att_q_norm_g : p.att_k_norm_g) + L * 64;
    const float* rope = (const float*)(p.ws + OFF_ROPE);
    const float qscale = nt <= 1 ? 0.125f * 1.4426950408889634f : 1.f;
    u16* dst = nt <= 1 ? (u16*)(p.ws + OFF_C0) : (u16*)(p.ws + OFF_AK);
    const int dstride = nt <= 1 ? 256 : 128;
    const int colbase = (nt <= 1 ? nt * 128 : 0) + wn * 64;
#pragma unroll
    for (int qt = 0; qt < QT; ++qt) {
      int token = m0 + wq * 128 + qt * 16 + l15;
      int tpos = token - sbase;
      int prow = tpos >> 6, pcol = tpos & 63;
      float ss = 0.f;
#pragma unroll
      for (int pt = 0; pt < 4; ++pt)
#pragma unroll
        for (int j = 0; j < 4; ++j) ss += acc[pt][qt][j] * acc[pt][qt][j];
      ss += __shfl_xor(ss, 16); ss += __shfl_xor(ss, 32);
      float r = rsqrtf(ss * (1.f / 64.f) + EPSF);
      float v[4][4];
#pragma unroll
      for (int pt = 0; pt < 4; ++pt)
#pragma unroll
        for (int j = 0; j < 4; ++j) v[pt][j] = acc[pt][qt][j] * r * g[pt * 16 + quad * 4 + j];
#pragma unroll
      for (int ax = 0; ax < 2; ++ax) {
        int pos = ax == 0 ? prow : pcol;
#pragma unroll
        for (int j = 0; j < 4; ++j) {
          float c = rope[pos * 16 + quad * 4 + j], s = rope[1024 + pos * 16 + quad * 4 + j];
          float x1 = v[2 * ax][j], x2 = v[2 * ax + 1][j];
          v[2 * ax][j] = (x1 * c - x2 * s) * qscale;
          v[2 * ax + 1][j] = (x2 * c + x1 * s) * qscale;
        }
      }
#pragma unroll
      for (int pt = 0; pt < 4; ++pt)
        *(uint2*)(dst + (size_t)token * dstride + colbase + pt * 16 + quad * 4) = make_uint2(pack2(v[pt][0], v[pt][1]), pack2(v[pt][2], v[pt][3]));
    }
  } else if (nt == 3) {
    u16* AVT = (u16*)(p.ws + OFF_AVT) + (size_t)sbase * 128;
#pragma unroll
    for (int qt = 0; qt < QT; ++qt) {
      int tpos = m0 + wq * 128 + qt * 16 + l15 - sbase;
#pragma unroll
      for (int pt = 0; pt < 4; ++pt)
#pragma unroll
        for (int j = 0; j < 4; ++j) {
          int n = wn * 64 + pt * 16 + quad * 4 + j;
          AVT[(size_t)n * slen + tpos] = f2bf(acc[pt][qt][j]);
        }
    }
  } else if (nt == 24) {
    float* SMALL = (float*)(p.ws + OFF_SMALL);
    if (wn == 0) {
#pragma unroll
      for (int qt = 0; qt < QT; ++qt) {
        int token = m0 + wq * 128 + qt * 16 + l15;
#pragma unroll
        for (int pt = 0; pt < 3; ++pt)
          *(float4*)(SMALL + (size_t)token * 48 + pt * 16 + quad * 4) = make_float4(acc[pt][qt][0], acc[pt][qt][1], acc[pt][qt][2], acc[pt][qt][3]);
      }
    }
  } else {
    u16* dst; int dstride, colbase; int mode = 0;
    const float* gvec = nullptr;
    if (nt <= 5) { dst = (u16*)(p.ws + OFF_AGATE); dstride = 256; colbase = (nt - 4) * 128; mode = 1; }
    else if (nt <= 11) { dst = (u16*)(p.ws + OFF_DQKV); dstride = 768; colbase = (nt - 6) * 128; }
    else if (nt <= 13) { dst = (u16*)(p.ws + OFF_DGATE); dstride = 256; colbase = (nt - 12) * 128; mode = 1; gvec = p.gdn_out_norm_g + L * 64; }
    else if (nt == 14) { dst = (u16*)(p.ws + OFF_LQ); dstride = 128; colbase = 0; }
    else if (nt == 15) { dst = (u16*)(p.ws + OFF_LK); dstride = 128; colbase = 0; }
    else if (nt <= 17) { dst = (u16*)(p.ws + OFF_LV); dstride = 256; colbase = (nt - 16) * 128; }
    else if (nt <= 19) { dst = (u16*)(p.ws + OFF_LGATE); dstride = 256; colbase = (nt - 18) * 128; mode = 1; gvec = p.gla_out_norm_g + L * 64; }
    else if (nt <= 21) { dst = (u16*)(p.ws + OFF_C3); dstride = 256; colbase = (nt - 20) * 128; mode = 2; }
    else { dst = (u16*)(p.ws + OFF_MGATE); dstride = 256; colbase = (nt - 22) * 128; mode = 1; }
    u16* bp = dst + (size_t)(m0 + wq * 128 + l15) * dstride + colbase + wn * 64 + quad * 4;
    const bool is_dqkv = (nt >= 6 && nt <= 11);
    u16* halo = (u16*)(p.ws + OFF_HALO) + (size_t)(mt * 2 + wq) * 2 * 768 + colbase + wn * 64 + quad * 4;
#pragma unroll
    for (int qt = 0; qt < QT; ++qt) {
      u16* rp = bp + (size_t)(qt * 16) * dstride;
#pragma unroll
      for (int pt = 0; pt < 4; ++pt) {
        float v[4];
#pragma unroll
        for (int j = 0; j < 4; ++j) {
          float x = acc[pt][qt][j];
          v[j] = mode == 1 ? siluf(x) : (mode == 2 ? x * (0.125f * 1.4426950408889634f) : x);
        }
        if (gvec) {
          float4 gg = *(const float4*)(gvec + pt * 16 + quad * 4);
          v[0] *= gg.x; v[1] *= gg.y; v[2] *= gg.z; v[3] *= gg.w;
        }
        u32x2 pk = {pack2(v[0], v[1]), pack2(v[2], v[3])};
        *(u32x2*)(rp + pt * 16) = pk;
        if (is_dqkv) {
          if (qt == 0 && l15 == 0) *(u32x2*)(halo + pt * 16) = pk;
          if (qt == QT - 1 && l15 == 15) *(u32x2*)(halo + 768 + pt * 16) = pk;
        }
      }
    }
  }
}

DI void g3_tile(const Params& p, int L, int tile, u16* smem) {
  const int mt = tile >> 2, nt = tile & 3;
  const int m0 = mt * TM, n0 = nt * 128;
  const int tid = otid(), lane = tid & 63, wave = tid >> 6;
  const int wn = wave & 1, wq = wave >> 1, l15 = lane & 15, quad = lane >> 4;
  float* rstd_s = (float*)(smem + 384 * LDS_STRIDE);
  __syncthreads();
  rstd_s[tid] = ((const float*)(p.ws + OFF_MEMRSTD))[m0 + tid];
  f32x4 acc[4][QT];
  QSrc q; int mloc;
  if (m0 < 2048) { q.base = p.mem_prompt; mloc = m0; } else { q.base = p.mem_sample; mloc = m0 - 2048; }
  q.ldq = 1024;
  const u16* W = (const u16*)(p.ws + OFF_WMKV) + ((size_t)L * 512 + n0) * 1024;
  gemm_core<1>(acc, W, q, mloc, smem);
  u16* KM = (u16*)(p.ws + OFF_KM);
  u16* VMT = (u16*)(p.ws + OFF_VMT);
#pragma unroll
  for (int qt = 0; qt < QT; ++qt) {
    int r = m0 + wq * 128 + qt * 16 + l15;
    float rs = rstd_s[wq * 128 + qt * 16 + l15];
    int b = r >> 8, m = r & 255;
#pragma unroll
    for (int pt = 0; pt < 4; ++pt) {
      int n = n0 + wn * 64 + pt * 16 + quad * 4;
      if (n < 256) {
        *(uint2*)(KM + (size_t)r * 256 + n) = make_uint2(pack2(acc[pt][qt][0] * rs, acc[pt][qt][1] * rs), pack2(acc[pt][qt][2] * rs, acc[pt][qt][3] * rs));
      } else {
#pragma unroll
        for (int j = 0; j < 4; ++j) {
          int nn = n + j - 256;
          VMT[((size_t)b * 256 + nn) * 256 + m] = f2bf(acc[pt][qt][j] * rs);
        }
      }
    }
  }
}

DI void g2_tile(const Params& p, int L, int tile, u16* smem) {
  int mt, nt;
  {
    const int xcd = tile & 7, lb = (tile & 511) >> 3, rnd = tile >> 9;
    const int j = lb + 64 * rnd;
    const int rr = j & 63;
    mt = xcd * 32 + (j >> 6) * 8 + (rr & 7); nt = rr >> 3;
  }
  const int m0 = mt * TM, n0 = nt * 128;
  const int tid = otid(), lane = tid & 63, wave = tid >> 6;
  const int wn = wave & 1, wq = wave >> 1, l15 = lane & 15, quad = lane >> 4;
  f32x4 acc[4][QT];
  QSrc q; q.base = nullptr; q.ldq = 0;
  q.c0 = (const u16*)(p.ws + OFF_C0); q.c1 = (const u16*)(p.ws + OFF_C1);
  q.c2 = (const u16*)(p.ws + OFF_C2); q.c3 = (const u16*)(p.ws + OFF_C3);
  const u16* W = (const u16*)(p.ws + OFF_WOUT) + ((size_t)L * 1024 + n0) * 1024;
  gemm_core<2>(acc, W, q, m0, smem);
  u16* HI = (u16*)p.out; u16* LO = HI + (size_t)T_TOK * 1024;
  float* SUMSQ = (float*)(p.ws + OFF_SUMSQ);
  float* HF = (float*)(p.ws + OFF_HFINAL);
#pragma unroll
  for (int qt = 0; qt < QT; ++qt) {
    int token = m0 + wq * 128 + qt * 16 + l15;
    float ss = 0.f;
#pragma unroll
    for (int pt = 0; pt < 4; ++pt) {
      int n = n0 + wn * 64 + pt * 16 + quad * 4;
      size_t idx = (size_t)token * 1024 + n;
      uint2 h = *(const uint2*)(HI + idx);
      float v[4];
      v[0] = bf2f(h.x & 0xffff) + acc[pt][qt][0];
      v[1] = bf2f(h.x >> 16) + acc[pt][qt][1];
      v[2] = bf2f(h.y & 0xffff) + acc[pt][qt][2];
      v[3] = bf2f(h.y >> 16) + acc[pt][qt][3];
#pragma unroll
      for (int j = 0; j < 4; ++j) ss += v[j] * v[j];
      if (L == 3) {
        *(float4*)(HF + idx) = make_float4(v[0], v[1], v[2], v[3]);
      } else {
        *(uint2*)(HI + idx) = make_uint2(pack2(v[0], v[1]), pack2(v[2], v[3]));
      }
    }
    ss += __shfl_xor(ss, 16); ss += __shfl_xor(ss, 32);
    if (quad == 0) SUMSQ[(size_t)token * 16 + nt * 2 + wn] = ss;
  }
}

DI void attn_block(u16* Qp, const u16* Kp, int kstride, const u16* VTp, int Lk, const u16* Gp, u16* smem) {
  const int tid = otid(), lane = tid & 63, wave = tid >> 6;
  const int l15 = lane & 15, quad = lane >> 4;
  u16* Ks = smem; u16* Vs = smem + 64 * LDS_STRIDE;
  bf16x8 qf[2][2];
#pragma unroll
  for (int qt = 0; qt < 2; ++qt)
#pragma unroll
    for (int ks = 0; ks < 2; ++ks)
      qf[qt][ks] = *(const bf16x8*)(Qp + (size_t)(wave * 32 + qt * 16 + l15) * 256 + ks * 32 + quad * 8);
  f32x4 o[4][2];
#pragma unroll
  for (int a = 0; a < 4; ++a)
#pragma unroll
    for (int b = 0; b < 2; ++b) o[a][b] = (f32x4){0.f, 0.f, 0.f, 0.f};
  float mrun[2] = {-1e30f, -1e30f}, lsum[2] = {0.f, 0.f};
  u32x4 kr[2], vr[2];
  const int nkt = Lk >> 6;
#pragma unroll
  for (int i = 0; i < 2; ++i) {
    int c = tid + 256 * i; int row = c >> 3, kc = c & 7;
    kr[i] = *(const u32x4*)(Kp + (size_t)row * kstride + kc * 8);
    vr[i] = *(const u32x4*)(VTp + (size_t)row * Lk + kc * 8);
  }
#pragma unroll 1
  for (int kt = 0; kt < nkt; ++kt) {
    __syncthreads();
#pragma unroll
    for (int i = 0; i < 2; ++i) {
      int c = tid + 256 * i; int row = c >> 3, kc = c & 7;
      *(u32x4*)(Ks + row * LDS_STRIDE + kc * 8) = kr[i];
      *(u32x4*)(Vs + row * LDS_STRIDE + kc * 8) = vr[i];
    }
    __syncthreads();
    if (kt + 1 < nkt) {
      int key0 = (kt + 1) * 64;
#pragma unroll
      for (int i = 0; i < 2; ++i) {
        int c = tid + 256 * i; int row = c >> 3, kc = c & 7;
        kr[i] = *(const u32x4*)(Kp + (size_t)(key0 + row) * kstride + kc * 8);
        vr[i] = *(const u32x4*)(VTp + (size_t)row * Lk + key0 + kc * 8);
      }
    }
    f32x4 s[4][2];
#pragma unroll
    for (int a = 0; a < 4; ++a)
#pragma unroll
      for (int b = 0; b < 2; ++b) s[a][b] = (f32x4){0.f, 0.f, 0.f, 0.f};
#pragma unroll
    for (int ks = 0; ks < 2; ++ks)
#pragma unroll
      for (int k4 = 0; k4 < 4; ++k4) {
        bf16x8 kf = *(const bf16x8*)(Ks + (k4 * 16 + l15) * LDS_STRIDE + ks * 32 + quad * 8);
#pragma unroll
        for (int qt = 0; qt < 2; ++qt) s[k4][qt] = mfma16(kf, qf[qt][ks], s[k4][qt]);
      }
    bf16x8 pq[2][2];
#pragma unroll
    for (int qt = 0; qt < 2; ++qt) {
      float mx = -1e30f;
#pragma unroll
      for (int k4 = 0; k4 < 4; ++k4)
#pragma unroll
        for (int j = 0; j < 4; ++j) mx = fmaxf(mx, s[k4][qt][j]);
      mx = fmaxf(mx, __shfl_xor(mx, 16)); mx = fmaxf(mx, __shfl_xor(mx, 32));
      float mn = fmaxf(mrun[qt], mx);
      float alpha = fast_exp2(mrun[qt] - mn);
      mrun[qt] = mn;
      float ps = 0.f;
#pragma unroll
      for (int k4 = 0; k4 < 4; ++k4)
#pragma unroll
        for (int j = 0; j < 4; ++j) { float e = fast_exp2(s[k4][qt][j] - mn); s[k4][qt][j] = e; ps += e; }
      lsum[qt] = lsum[qt] * alpha + ps;
#pragma unroll
      for (int dt = 0; dt < 4; ++dt)
#pragma unroll
        for (int j = 0; j < 4; ++j) o[dt][qt][j] *= alpha;
#pragma unroll
      for (int k2 = 0; k2 < 2; ++k2) {
        u32x4 u = (u32x4){pack2(s[2 * k2][qt][0], s[2 * k2][qt][1]), pack2(s[2 * k2][qt][2], s[2 * k2][qt][3]),
                          pack2(s[2 * k2 + 1][qt][0], s[2 * k2 + 1][qt][1]), pack2(s[2 * k2 + 1][qt][2], s[2 * k2 + 1][qt][3])};
        pq[qt][k2] = __builtin_bit_cast(bf16x8, u);
      }
    }
#pragma unroll
    for (int dt = 0; dt < 4; ++dt)
#pragma unroll
      for (int k2 = 0; k2 < 2; ++k2) {
        const u16* vrow = Vs + (dt * 16 + l15) * LDS_STRIDE + quad * 4;
        u32x2 a = *(const u32x2*)(vrow + (2 * k2) * 16), b = *(const u32x2*)(vrow + (2 * k2 + 1) * 16);
        bf16x8 vf = __builtin_bit_cast(bf16x8, (u32x4){a.x, a.y, b.x, b.y});
#pragma unroll
        for (int qt = 0; qt < 2; ++qt) o[dt][qt] = mfma16(vf, pq[qt][k2], o[dt][qt]);
      }
  }
#pragma unroll
  for (int qt = 0; qt < 2; ++qt) {
    float l = lsum[qt];
    l += __shfl_xor(l, 16); l += __shfl_xor(l, 32);
    float inv = 1.f / l;
    size_t rowoff = (size_t)(wave * 32 + qt * 16 + l15) * 256;
#pragma unroll
    for (int dt = 0; dt < 4; ++dt) {
      uint2 g = *(const uint2*)(Gp + rowoff + dt * 16 + quad * 4);
      float v0 = o[dt][qt][0] * inv * bf2f(g.x & 0xffff), v1 = o[dt][qt][1] * inv * bf2f(g.x >> 16);
      float v2 = o[dt][qt][2] * inv * bf2f(g.y & 0xffff), v3 = o[dt][qt][3] * inv * bf2f(g.y >> 16);
      *(uint2*)(Qp + rowoff + dt * 16 + quad * 4) = make_uint2(pack2(v0, v1), pack2(v2, v3));
    }
  }
}

DI float softplusf(float x) { return fmaxf(x, 0.f) + flog(1.f + fexp(-fabsf(x))); }
DI float logsigmoidf(float x) { return fminf(x, 0.f) - flog(1.f + fexp(-fabsf(x))); }

DI void scan_block_naive(const Params& p, int L, int seq, int h, u16* smem) {
  const int tid = otid(), lane = tid & 63, wave = tid >> 6;
  const int dir = wave & 1, kind = wave >> 1;
  const int sbase = seq_base(seq), S = seq_len(seq);
  float* bc = (float*)smem + wave * 160;
  const u16* DQKV = (const u16*)(p.ws + OFF_DQKV) + (size_t)sbase * 768 + h * 64 + lane;
  const float* SMALL = (const float*)(p.ws + OFF_SMALL) + (size_t)sbase * 48;
  float St[64];
#pragma unroll
  for (int d = 0; d < 64; ++d) St[d] = 0.f;
  float cw[3][3];
#pragma unroll
  for (int i = 0; i < 3; ++i)
#pragma unroll
    for (int s = 0; s < 3; ++s) cw[i][s] = p.gdn_conv_w[((size_t)L * 3 + i) * 768 + s * 256 + h * 64 + lane];
  const float A = fexp(p.gdn_a_log[L * 8 + dir * 4 + h]);
  const float dtb = p.gdn_dt_bias[L * 8 + dir * 4 + h];
  const float onorm = (kind == 0 ? p.gdn_out_norm_g : p.gla_out_norm_g)[L * 64 + lane];
  float wup[16]; float bg = 0.f;
  {
    int d = lane & 31;
#pragma unroll
    for (int r = 0; r < 16; ++r) wup[r] = p.gla_w_gate_up[(((size_t)L * 2 + dir) * 16 + r) * 128 + h * 32 + d];
    bg = p.gla_b_gate[((size_t)L * 2 + dir) * 128 + h * 32 + d];
  }
  u16* OUT = (u16*)(p.ws + (kind == 0 ? OFF_C1 : OFF_C2)) + (size_t)sbase * 256 + h * 64 + lane;
  const u16* GATE = (const u16*)(p.ws + (kind == 0 ? OFF_DGATE : OFF_LGATE)) + (size_t)sbase * 256 + h * 64 + lane;
  const u16* LQ = (const u16*)(p.ws + OFF_LQ) + (size_t)sbase * 128 + h * 32;
  const u16* LK = (const u16*)(p.ws + OFF_LK) + (size_t)sbase * 128 + h * 32;
  const u16* LV = (const u16*)(p.ws + OFF_LV) + (size_t)sbase * 256 + h * 64 + lane;
  const int step = dir ? -1 : 1;
  int t = dir ? S - 1 : 0;
  float rb[3], r0[3], r1[3], r2[3];
#pragma unroll
  for (int s = 0; s < 3; ++s) {
    rb[s] = 0.f;
    r0[s] = bf2f(DQKV[(size_t)t * 768 + s * 256]);
    r1[s] = bf2f(DQKV[(size_t)(t + step) * 768 + s * 256]);
    r2[s] = bf2f(DQKV[(size_t)(t + 2 * step) * 768 + s * 256]);
  }
#pragma unroll 1
  for (int n = 0; n < S; ++n, t += step) {
    float o;
    if (kind == 0) {
      float cv[3];
#pragma unroll
      for (int s = 0; s < 3; ++s) {
        float xm = dir ? r1[s] : rb[s], xp = dir ? rb[s] : r1[s];
        cv[s] = siluf(xm * cw[0][s] + r0[s] * cw[1][s] + xp * cw[2][s]);
      }
      float ssq = wave_sum(cv[0] * cv[0]), ssk = wave_sum(cv[1] * cv[1]);
      float qn = cv[0] * rsqrtf(ssq + EPSF), kn = cv[1] * rsqrtf(ssk + EPSF);
      bc[lane] = qn; bc[64 + lane] = kn;
      float beta = 1.f / (1.f + fexp(-SMALL[(size_t)t * 48 + dir * 4 + h]));
      float g = -A * softplusf(SMALL[(size_t)t * 48 + 8 + dir * 4 + h] + dtb);
      float eg = fexp(g);
#pragma unroll
      for (int s = 0; s < 3; ++s) { rb[s] = r0[s]; r0[s] = r1[s]; r1[s] = r2[s]; }
      int tn = t + 3 * step;
      bool ok = tn >= 0 && tn < S;
#pragma unroll
      for (int s = 0; s < 3; ++s) r2[s] = ok ? bf2f(DQKV[(size_t)tn * 768 + s * 256]) : 0.f;
      __builtin_amdgcn_wave_barrier();
      float kS = 0.f;
#pragma unroll
      for (int d4 = 0; d4 < 16; ++d4) {
        float4 kk = *(const float4*)(bc + 64 + d4 * 4);
        kS += kk.x * St[d4 * 4] + kk.y * St[d4 * 4 + 1] + kk.z * St[d4 * 4 + 2] + kk.w * St[d4 * 4 + 3];
      }
      float w = beta * (cv[2] - eg * kS);
      o = 0.f;
#pragma unroll
      for (int d4 = 0; d4 < 16; ++d4) {
        float4 kk = *(const float4*)(bc + 64 + d4 * 4);
        float4 qq = *(const float4*)(bc + d4 * 4);
        St[d4 * 4] = eg * St[d4 * 4] + kk.x * w; o += qq.x * St[d4 * 4];
        St[d4 * 4 + 1] = eg * St[d4 * 4 + 1] + kk.y * w; o += qq.y * St[d4 * 4 + 1];
        St[d4 * 4 + 2] = eg * St[d4 * 4 + 2] + kk.z * w; o += qq.z * St[d4 * 4 + 2];
        St[d4 * 4 + 3] = eg * St[d4 * 4 + 3] + kk.w * w; o += qq.w * St[d4 * 4 + 3];
      }
      o *= 0.125f;
      __builtin_amdgcn_wave_barrier();
    } else {
      float lg = bg;
      const float* low = SMALL + (size_t)t * 48 + 16 + dir * 16;
#pragma unroll
      for (int r = 0; r < 16; ++r) lg += low[r] * wup[r];
      float egk = fexp(logsigmoidf(lg) * (1.f / 16.f));
      float qk = lane < 32 ? bf2f(LQ[(size_t)t * 128 + lane]) : bf2f(LK[(size_t)t * 128 + lane - 32]);
      float v = bf2f(LV[(size_t)t * 256]);
      bc[lane] = qk;
      if (lane < 32) bc[64 + lane] = egk;
      __builtin_amdgcn_wave_barrier();
      o = 0.f;
#pragma unroll
      for (int d4 = 0; d4 < 8; ++d4) {
        float4 qq = *(const float4*)(bc + d4 * 4);
        float4 kk = *(const float4*)(bc + 32 + d4 * 4);
        float4 ee = *(const float4*)(bc + 64 + d4 * 4);
        St[d4 * 4] = ee.x * St[d4 * 4] + kk.x * v; o += qq.x * St[d4 * 4];
        St[d4 * 4 + 1] = ee.y * St[d4 * 4 + 1] + kk.y * v; o += qq.y * St[d4 * 4 + 1];
        St[d4 * 4 + 2] = ee.z * St[d4 * 4 + 2] + kk.z * v; o += qq.z * St[d4 * 4 + 2];
        St[d4 * 4 + 3] = ee.w * St[d4 * 4 + 3] + kk.w * v; o += qq.w * St[d4 * 4 + 3];
      }
      o *= 0.17677669529663687f;
      __builtin_amdgcn_wave_barrier();
    }
    if (n < (S >> 1)) {
      OUT[(size_t)t * 256] = f2bf(o);
    } else {
      float tot = o + bf2f(OUT[(size_t)t * 256]);
      float ss = wave_sum(tot * tot);
      float y = tot * rsqrtf(ss * (1.f / 64.f) + EPSF) * onorm * bf2f(GATE[(size_t)t * 256]);
      OUT[(size_t)t * 256] = f2bf(y);
    }
    __syncthreads();
  }
}

DI void conv_load32(float (&x)[32], const u16* src) {
#pragma unroll
  for (int i = 0; i < 4; ++i) {
    u32x4 r = *(const u32x4*)(src + i * 8);
#pragma unroll
    for (int j = 0; j < 4; ++j) { x[i * 8 + 2 * j] = bf2f(r[j] & 0xffff); x[i * 8 + 2 * j + 1] = bf2f(r[j] >> 16); }
  }
}
DI void prep_task(const Params& p, int L, int task, u16* smem) {
  const int mt = task >> 2, h = task & 3;
  const int m0 = mt * 128;
  const int tid = otid(), tok = tid >> 1, half = tid & 1;
  const int seq = seq_of_token(m0), sbase = seq_base(seq), S = seq_len(seq);
  const int token = m0 + tok, tpos = token - sbase;
  u16* DQ = (u16*)(p.ws + OFF_DQKV);
  const u16* HALO = (const u16*)(p.ws + OFF_HALO);
  u16* LV = (u16*)(p.ws + OFF_LV);
  u32x4 raw[3][3][4];
  const float scp = tpos > 0 ? 1.f : 0.f, scn = tpos < S - 1 ? 1.f : 0.f;
#pragma unroll
  for (int s = 0; s < 3; ++s) {
    const int col0 = s * 256 + h * 64 + half * 32;
    const u16* pc = DQ + (size_t)token * 768 + col0;
    const u16* pp = tpos > 0 ? (tok > 0 ? pc - 768 : HALO + ((size_t)(mt - 1) * 2 + 1) * 768 + col0) : pc;
    const u16* pn = tpos < S - 1 ? (tok < 127 ? pc + 768 : HALO + ((size_t)(mt + 1) * 2 + 0) * 768 + col0) : pc;
#pragma unroll
    for (int i = 0; i < 4; ++i) { raw[s][0][i] = *(const u32x4*)(pp + i * 8); raw[s][1][i] = *(const u32x4*)(pc + i * 8); raw[s][2][i] = *(const u32x4*)(pn + i * 8); }
  }
  u32x4 res[3][4];
#pragma unroll
  for (int s = 0; s < 3; ++s) {
    const int col0 = s * 256 + h * 64 + half * 32;
    const float* w0 = p.gdn_conv_w + ((size_t)L * 3 + 0) * 768 + col0;
    const float* w1 = w0 + 768; const float* w2 = w0 + 2 * 768;
    float acc[32];
#pragma unroll
    for (int i = 0; i < 4; ++i)
#pragma unroll
      for (int j = 0; j < 4; ++j) {
        const int c = i * 8 + 2 * j;
        const uint32_t rp = raw[s][0][i][j], rc = raw[s][1][i][j], rn = raw[s][2][i][j];
        acc[c] = bf2f(rc & 0xffff) * w1[c] + scp * (bf2f(rp & 0xffff) * w0[c]) + scn * (bf2f(rn & 0xffff) * w2[c]);
        acc[c + 1] = bf2f(rc >> 16) * w1[c + 1] + scp * (bf2f(rp >> 16) * w0[c + 1]) + scn * (bf2f(rn >> 16) * w2[c + 1]);
      }
    float ss = 0.f;
#pragma unroll
    for (int c = 0; c < 32; ++c) { acc[c] = siluf(acc[c]); ss += acc[c] * acc[c]; }
    float sc = 1.f;
    if (s < 2) { ss += __shfl_xor(ss, 1); sc = rsqrtf(ss + EPSF); }
#pragma unroll
    for (int i = 0; i < 4; ++i)
      res[s][i] = (u32x4){pack2(acc[i * 8] * sc, acc[i * 8 + 1] * sc), pack2(acc[i * 8 + 2] * sc, acc[i * 8 + 3] * sc),
                          pack2(acc[i * 8 + 4] * sc, acc[i * 8 + 5] * sc), pack2(acc[i * 8 + 6] * sc, acc[i * 8 + 7] * sc)};
  }
  __syncthreads();
#pragma unroll
  for (int s = 0; s < 3; ++s)
#pragma unroll
    for (int i = 0; i < 4; ++i) *(u32x4*)(DQ + (size_t)token * 768 + s * 256 + h * 64 + half * 32 + i * 8) = res[s][i];
}

DI bf16x8 pk8(f32x4 a, f32x4 b) { u32x4 u = {pack2(a[0], a[1]), pack2(a[2], a[3]), pack2(b[0], b[1]), pack2(b[2], b[3])}; return __builtin_bit_cast(bf16x8, u); }
DI bf16x8 pk4(f32x4 a) { u32x4 u = {pack2(a[0], a[1]), pack2(a[2], a[3]), 0u, 0u}; return __builtin_bit_cast(bf16x8, u); }
DI bf16x8 pk8n(f32x4 a, f32x4 b) { u32x4 u = {pack2(-a[0], -a[1]), pack2(-a[2], -a[3]), pack2(-b[0], -b[1]), pack2(-b[2], -b[3])}; return __builtin_bit_cast(bf16x8, u); }
DI u32x2 rev4(u32x2 v) { u32x2 r = {(v.y >> 16) | (v.y << 16), (v.x >> 16) | (v.x << 16)}; return r; }
DI f32x4 unpack4(u32x2 v) { f32x4 r = {bf2f(v.x & 0xffff), bf2f(v.x >> 16), bf2f(v.y & 0xffff), bf2f(v.y >> 16)}; return r; }
#define F4Z ((f32x4){0.f, 0.f, 0.f, 0.f})

DI void scan_combine(u16* OUT, const u16* SLOT, int slot_stride, const u16* GATE, int S, int tid) {
  const int q4 = (tid & 3) * 16;
#pragma unroll 1
  for (int t0 = 0; t0 < S; t0 += 128) {
    u32x4 a[2][2], b[2][2], g[2][2];
#pragma unroll
    for (int k = 0; k < 2; ++k) {
      size_t tok = (size_t)(t0 + k * 64 + (tid >> 2));
#pragma unroll
      for (int i = 0; i < 2; ++i) {
        a[k][i] = *(const u32x4*)(OUT + tok * 256 + q4 + i * 8);
        b[k][i] = *(const u32x4*)(SLOT + tok * slot_stride + q4 + i * 8);
        g[k][i] = *(const u32x4*)(GATE + tok * 256 + q4 + i * 8);
      }
    }
#pragma unroll
    for (int k = 0; k < 2; ++k) {
      size_t tok = (size_t)(t0 + k * 64 + (tid >> 2));
      float v[16]; float ss = 0.f;
#pragma unroll
      for (int i = 0; i < 2; ++i)
#pragma unroll
        for (int w = 0; w < 4; ++w) {
          float x0 = bf2f(a[k][i][w] & 0xffff) + bf2f(b[k][i][w] & 0xffff), x1 = bf2f(a[k][i][w] >> 16) + bf2f(b[k][i][w] >> 16);
          v[i * 8 + w * 2] = x0; v[i * 8 + w * 2 + 1] = x1; ss += x0 * x0 + x1 * x1;
        }
      ss += __shfl_xor(ss, 1); ss += __shfl_xor(ss, 2);
      const float r = rsqrtf(ss * (1.f / 64.f) + EPSF);
#pragma unroll
      for (int i = 0; i < 2; ++i) {
        u32x4 o;
#pragma unroll
        for (int w = 0; w < 4; ++w)
          o[w] = pack2(v[i * 8 + w * 2] * r * bf2f(g[k][i][w] & 0xffff), v[i * 8 + w * 2 + 1] * r * bf2f(g[k][i][w] >> 16));
        *(u32x4*)(OUT + tok * 256 + q4 + i * 8) = o;
      }
    }
  }
}

#define SCAN_R 2
#define SCAN_SLOT_V4 10
DI void ring_wait(volatile int* f, int v) { while (*f < v) __builtin_amdgcn_s_sleep(1); }

DI void dn_task(const Params& p, int L, int seq, int h, u16* smem) {
  const int tid = otid(), lane = tid & 63, wave = tid >> 6, l15 = lane & 15, quad = lane >> 4;
  const int dir = wave >> 1, role = wave & 1;
  const int sbase = seq_base(seq), S = seq_len(seq), N = S >> 4;
  u32x4* slots = (u32x4*)smem + (size_t)dir * SCAN_R * SCAN_SLOT_V4 * 64 + lane;
  volatile int* ready = (volatile int*)(smem + 20480) + dir * 8;
  volatile int* done = ready + 4;
  __syncthreads();
  if (tid < 16) ((volatile int*)(smem + 20480))[tid] = 0;
  __syncthreads();
  u16* OUT = (u16*)(p.ws + OFF_C1) + (size_t)sbase * 256 + h * 64;
  u16* SLOT = (u16*)(p.ws + OFF_DQKV) + (size_t)sbase * 768 + h * 64;
  if (role == 0) {
    const u16* QK = (const u16*)(p.ws + OFF_DQKV) + (size_t)sbase * 768 + h * 64;
    const float* SM = (const float*)(p.ws + OFF_SMALL) + (size_t)sbase * 48 + dir * 4 + h;
    const float A = fexp(p.gdn_a_log[L * 8 + dir * 4 + h]);
    const float dtb = p.gdn_dt_bias[L * 8 + dir * 4 + h];
    bf16x8 selE, selO;
    {
      uint32_t w = ((l15 >> 2) == quad) ? (0x3F80u << ((l15 & 1) * 16)) : 0u;
      uint32_t w0 = (l15 & 2) ? 0u : w, w1 = (l15 & 2) ? w : 0u;
      selE = __builtin_bit_cast(bf16x8, (u32x4){w0, w1, 0u, 0u});
      selO = __builtin_bit_cast(bf16x8, (u32x4){0u, 0u, w0, w1});
    }
    const int ca0 = dir ? 12 - quad * 4 : quad * 4;
    u32x2 qraw[4], kraw[4], vraw[4]; float braw, graw;
    auto load_step = [&](int n) {
      int t0 = dir ? S - 16 * (n + 1) : 16 * n;
      int rl = dir ? t0 + 15 - l15 : t0 + l15;
      const u16* qrow = QK + (size_t)rl * 768;
#pragma unroll
      for (int s = 0; s < 2; ++s) {
        qraw[2 * s] = *(const u32x2*)(qrow + 32 * s + quad * 4);
        qraw[2 * s + 1] = *(const u32x2*)(qrow + 32 * s + 16 + quad * 4);
        kraw[2 * s] = *(const u32x2*)(qrow + 256 + 32 * s + quad * 4);
        kraw[2 * s + 1] = *(const u32x2*)(qrow + 256 + 32 * s + 16 + quad * 4);
      }
#pragma unroll
      for (int s = 0; s < 2; ++s) {
        vraw[2 * s] = *(const u32x2*)(qrow + 512 + 32 * s + quad * 4);
        vraw[2 * s + 1] = *(const u32x2*)(qrow + 512 + 32 * s + 16 + quad * 4);
      }
      braw = SM[(size_t)rl * 48]; graw = SM[(size_t)rl * 48 + 8];
    };
#pragma unroll 1
    for (int half = 0; half < 2; ++half) {
      const int nbeg = half * (N >> 1), nend = nbeg + (N >> 1);
      load_step(nbeg);
      asm volatile("" ::: "memory");
#pragma unroll 1
      for (int n = nbeg; n < nend; ++n) {
        bf16x8 qn[2], kn[2];
#pragma unroll
        for (int s = 0; s < 2; ++s) {
          qn[s] = __builtin_bit_cast(bf16x8, (u32x4){qraw[2 * s].x, qraw[2 * s].y, qraw[2 * s + 1].x, qraw[2 * s + 1].y});
          kn[s] = __builtin_bit_cast(bf16x8, (u32x4){kraw[2 * s].x, kraw[2 * s].y, kraw[2 * s + 1].x, kraw[2 * s + 1].y});
        }
        bf16x8 vn[2];
#pragma unroll
        for (int s = 0; s < 2; ++s) vn[s] = __builtin_bit_cast(bf16x8, (u32x4){vraw[2 * s].x, vraw[2 * s].y, vraw[2 * s + 1].x, vraw[2 * s + 1].y});
        float cb = braw, cg = graw;
        load_step(n + 1 < nend ? n + 1 : n);
        asm volatile("" : "+v"(qn[0]), "+v"(qn[1]), "+v"(kn[0]), "+v"(kn[1]), "+v"(cb), "+v"(cg), "+v"(vn[0]), "+v"(vn[1]) :: "memory");
        f32x4 VC[4];
#pragma unroll
        for (int et = 0; et < 4; ++et) VC[et] = mfma16(vn[et >> 1], (et & 1) ? selO : selE, F4Z);
        const float beta_l = 1.f / (1.f + fexp(-cb));
        float b_l = -A * softplusf(cg + dtb);
#pragma unroll
        for (int o = 1; o < 16; o <<= 1) { float t = __shfl_up(b_l, o, 16); if (l15 >= o) b_l += t; }
        float bq[4], betaq[4];
#pragma unroll
        for (int j = 0; j < 4; ++j) { bq[j] = __shfl(b_l, quad * 4 + j); betaq[j] = __shfl(beta_l, quad * 4 + j); }
        const float blast = __shfl(b_l, 15);
        const float cd = fexp(blast);
        bf16x8 rup[4], rwp[4], kdp[4];
#pragma unroll
        for (int t = 0; t < 4; ++t) {
          f32x4 KC = mfma16(kn[t >> 1], (t & 1) ? selO : selE, F4Z);
          f32x4 ru, rw, kd;
#pragma unroll
          for (int j = 0; j < 4; ++j) {
            ru[j] = betaq[j] * VC[t][j];
            rw[j] = betaq[j] * fexp(bq[j]) * KC[j];
            kd[j] = KC[j] * fexp(blast - bq[j]);
          }
          rup[t] = pk4(ru); rwp[t] = pk4(rw); kdp[t] = pk4(kd);
        }
        f32x4 kk = mfma16(kn[0], kn[0], F4Z); kk = mfma16(kn[1], kn[1], kk);
        f32x4 kq = mfma16(kn[0], qn[0], F4Z); kq = mfma16(kn[1], qn[1], kq);
        f32x4 P1, Q1, Z, AT;
#pragma unroll
        for (int j = 0; j < 4; ++j) {
          int r = quad * 4 + j;
          float ef = fexp(fminf(b_l - bq[j], 0.f));
          P1[j] = (r > l15) ? betaq[j] * kk[j] * fexp(fminf(bq[j] - b_l, 0.f)) : 0.f;
          Q1[j] = (l15 > r) ? beta_l * kk[j] * ef : 0.f;
          Z[j] = (r == l15 ? 1.f : 0.f) - Q1[j];
          AT[j] = (l15 >= r) ? kq[j] * 0.125f * ef : 0.f;
        }
        const bf16x8 atp = pk4(AT);
        {
          bf16x8 p1 = pk4(P1), q1 = pk4(Q1);
          f32x4 P2 = mfma16(q1, p1, F4Z), Q2 = mfma16(p1, q1, F4Z);
          bf16x8 p2 = pk4(P2), q2 = pk4(Q2);
          Z = mfma16(p2, pk4(Z), Z);
          f32x4 P4 = mfma16(q2, p2, F4Z), Q4 = mfma16(p2, q2, F4Z);
          bf16x8 p4 = pk4(P4), q4 = pk4(Q4);
          Z = mfma16(p4, pk4(Z), Z);
          f32x4 P8 = mfma16(q4, p4, F4Z);
          Z = mfma16(pk4(P8), pk4(Z), Z);
        }
        const bf16x8 zp = pk4(Z);
        bf16x8 wn0, wn1;
        {
          f32x4 w0 = mfma16(rwp[0], zp, F4Z), w1 = mfma16(rwp[1], zp, F4Z);
          wn0 = pk8n(w0, w1);
          f32x4 w2 = mfma16(rwp[2], zp, F4Z), w3 = mfma16(rwp[3], zp, F4Z);
          wn1 = pk8n(w2, w3);
        }
        const float eq_l = 0.125f * fexp(b_l);
        const int slot = n & (SCAN_R - 1);
        ring_wait(done + slot, n - SCAN_R + 1);
        asm volatile("" ::: "memory");
        u32x4* sp = slots + slot * SCAN_SLOT_V4 * 64;
        const u32x4 zz = __builtin_bit_cast(u32x4, zp), aa = __builtin_bit_cast(u32x4, atp);
        const u32x4 r0 = __builtin_bit_cast(u32x4, rup[0]), r1 = __builtin_bit_cast(u32x4, rup[1]), r2 = __builtin_bit_cast(u32x4, rup[2]), r3 = __builtin_bit_cast(u32x4, rup[3]);
        const u32x4 k0 = __builtin_bit_cast(u32x4, kdp[0]), k1 = __builtin_bit_cast(u32x4, kdp[1]), k2 = __builtin_bit_cast(u32x4, kdp[2]), k3 = __builtin_bit_cast(u32x4, kdp[3]);
        sp[0 * 64] = (u32x4){zz.x, zz.y, aa.x, aa.y};
        sp[1 * 64] = (u32x4){r0.x, r0.y, r1.x, r1.y};
        sp[2 * 64] = (u32x4){r2.x, r2.y, r3.x, r3.y};
        sp[3 * 64] = __builtin_bit_cast(u32x4, wn0);
        sp[4 * 64] = __builtin_bit_cast(u32x4, wn1);
        sp[5 * 64] = __builtin_bit_cast(u32x4, qn[0]);
        sp[6 * 64] = __builtin_bit_cast(u32x4, qn[1]);
        sp[7 * 64] = (u32x4){k0.x, k0.y, k1.x, k1.y};
        sp[8 * 64] = (u32x4){k2.x, k2.y, k3.x, k3.y};
        sp[9 * 64] = (u32x4){__float_as_uint(eq_l), __float_as_uint(cd), 0u, 0u};
        asm volatile("s_waitcnt lgkmcnt(0)" ::: "memory");
        ready[slot] = n + 1;
        asm volatile("" ::: "memory");
      }
      __syncthreads();
    }
  } else {
    f32x4 St[4][4];
#pragma unroll
    for (int a2 = 0; a2 < 4; ++a2)
#pragma unroll
      for (int b2 = 0; b2 < 4; ++b2) St[a2][b2] = F4Z;
    u32x2 rpk[4] = {(u32x2){0u, 0u}, (u32x2){0u, 0u}, (u32x2){0u, 0u}, (u32x2){0u, 0u}};
    u16* prev_ptr = OUT + (size_t)(dir ? S - 1 - l15 : l15) * 256 + quad * 4;
#pragma unroll 1
    for (int half = 0; half < 2; ++half) {
      const int nbeg = half * (N >> 1), nend = nbeg + (N >> 1);
#pragma unroll 1
      for (int n = nbeg; n < nend; ++n) {
        const int t0 = dir ? S - 16 * (n + 1) : 16 * n;
#pragma unroll
        for (int et = 0; et < 4; ++et) *(u32x2*)(prev_ptr + et * 16) = rpk[et];
        {
          const size_t row = (size_t)(dir ? t0 + 15 - l15 : t0 + l15);
          prev_ptr = half == 0 ? OUT + row * 256 + quad * 4 : SLOT + row * 768 + quad * 4;
        }
        const int slot = n & (SCAN_R - 1);
        ring_wait(ready + slot, n + 1);
        asm volatile("" ::: "memory");
        const u32x4* sp = slots + slot * SCAN_SLOT_V4 * 64;
        const u32x4 m0 = sp[0 * 64], m1 = sp[1 * 64], m2 = sp[2 * 64], m3 = sp[3 * 64], m4 = sp[4 * 64], m5 = sp[5 * 64], m6 = sp[6 * 64], m7 = sp[7 * 64], m8 = sp[8 * 64], m9 = sp[9 * 64];
        asm volatile("s_waitcnt lgkmcnt(0)" ::: "memory");
        done[slot] = n + 1;
        asm volatile("" ::: "memory");
        const bf16x8 zp = __builtin_bit_cast(bf16x8, (u32x4){m0.x, m0.y, 0u, 0u}), atp = __builtin_bit_cast(bf16x8, (u32x4){m0.z, m0.w, 0u, 0u});
        bf16x8 rup[4], kdp[4];
        rup[0] = __builtin_bit_cast(bf16x8, (u32x4){m1.x, m1.y, 0u, 0u}); rup[1] = __builtin_bit_cast(bf16x8, (u32x4){m1.z, m1.w, 0u, 0u});
        rup[2] = __builtin_bit_cast(bf16x8, (u32x4){m2.x, m2.y, 0u, 0u}); rup[3] = __builtin_bit_cast(bf16x8, (u32x4){m2.z, m2.w, 0u, 0u});
        kdp[0] = __builtin_bit_cast(bf16x8, (u32x4){m7.x, m7.y, 0u, 0u}); kdp[1] = __builtin_bit_cast(bf16x8, (u32x4){m7.z, m7.w, 0u, 0u});
        kdp[2] = __builtin_bit_cast(bf16x8, (u32x4){m8.x, m8.y, 0u, 0u}); kdp[3] = __builtin_bit_cast(bf16x8, (u32x4){m8.z, m8.w, 0u, 0u});
        const bf16x8 wn0 = __builtin_bit_cast(bf16x8, m3), wn1 = __builtin_bit_cast(bf16x8, m4);
        const bf16x8 qn0 = __builtin_bit_cast(bf16x8, m5), qn1 = __builtin_bit_cast(bf16x8, m6);
        const float eq_l = __uint_as_float(m9.x), cd = __uint_as_float(m9.y);
        f32x4 O[4];
#pragma unroll
        for (int et = 0; et < 4; ++et) {
          const bf16x8 s01 = pk8(St[0][et], St[1][et]), s23 = pk8(St[2][et], St[3][et]);
          f32x4 vn = mfma16(zp, rup[et], F4Z);
          vn = mfma16(wn0, s01, vn);
          vn = mfma16(wn1, s23, vn);
          f32x4 t1 = mfma16(s01, qn0, F4Z);
          t1 = mfma16(s23, qn1, t1);
#pragma unroll
          for (int j = 0; j < 4; ++j) t1[j] *= eq_l;
          const bf16x8 vnp = pk4(vn);
          O[et] = mfma16(vnp, atp, t1);
#pragma unroll
          for (int dt = 0; dt < 4; ++dt) {
            f32x4 c = St[dt][et];
#pragma unroll
            for (int j = 0; j < 4; ++j) c[j] *= cd;
            St[dt][et] = mfma16(kdp[dt], vnp, c);
          }
        }
#pragma unroll
        for (int et = 0; et < 4; ++et) rpk[et] = (u32x2){pack2(O[et][0], O[et][1]), pack2(O[et][2], O[et][3])};
      }
#pragma unroll
      for (int et = 0; et < 4; ++et) *(u32x2*)(prev_ptr + et * 16) = rpk[et];
      __syncthreads();
    }
  }
  scan_combine(OUT, SLOT, 768, (const u16*)(p.ws + OFF_DGATE) + (size_t)sbase * 256 + h * 64, S, tid);
}

DI void gla_task(const Params& p, int L, int seq, int h, u16* smem) {
  const int tid = otid(), lane = tid & 63, wave = tid >> 6, l15 = lane & 15, quad = lane >> 4;
  const int dir = wave >> 1, role = wave & 1;
  const int sbase = seq_base(seq), S = seq_len(seq), N = S >> 4;
  u32x4* slots = (u32x4*)smem + (size_t)dir * SCAN_R * SCAN_SLOT_V4 * 64 + lane;
  volatile int* ready = (volatile int*)(smem + 20480) + dir * 8;
  volatile int* done = ready + 4;
  __syncthreads();
  if (tid < 16) ((volatile int*)(smem + 20480))[tid] = 0;
  __syncthreads();
  u16* OUT = (u16*)(p.ws + OFF_C2) + (size_t)sbase * 256 + h * 64;
  u16* SLOT = (u16*)(p.ws + OFF_LV) + (size_t)sbase * 256 + h * 64;
  if (role == 0) {
    const u16* LQ = (const u16*)(p.ws + OFF_LQ) + (size_t)sbase * 128 + h * 32;
    const u16* LK = (const u16*)(p.ws + OFF_LK) + (size_t)sbase * 128 + h * 32;
    const u16* LV = (const u16*)(p.ws + OFF_LV) + (size_t)sbase * 256 + h * 64;
    const float* SM = (const float*)(p.ws + OFF_SMALL) + (size_t)sbase * 48 + 16 + dir * 16;
    bf16x8 selE, selO, triB, wupB[2];
    float bias[2];
    {
      uint32_t w = ((l15 >> 2) == quad) ? (0x3F80u << ((l15 & 1) * 16)) : 0u;
      uint32_t w0 = (l15 & 2) ? 0u : w, w1 = (l15 & 2) ? w : 0u;
      selE = __builtin_bit_cast(bf16x8, (u32x4){w0, w1, 0u, 0u});
      selO = __builtin_bit_cast(bf16x8, (u32x4){0u, 0u, w0, w1});
      uint32_t t[2];
#pragma unroll
      for (int k = 0; k < 2; ++k) {
        uint32_t lo = (quad * 4 + 2 * k <= l15) ? 0x3F80u : 0u, hi = (quad * 4 + 2 * k + 1 <= l15) ? 0x3F80u : 0u;
        t[k] = lo | (hi << 16);
      }
      triB = __builtin_bit_cast(bf16x8, (u32x4){t[0], t[1], 0u, 0u});
#pragma unroll
      for (int tt = 0; tt < 2; ++tt) {
        const float* wsrc = p.gla_w_gate_up + (((size_t)L * 2 + dir) * 16 + quad * 4) * 128 + h * 32 + tt * 16 + l15;
        wupB[tt] = __builtin_bit_cast(bf16x8, (u32x4){pack2(wsrc[0], wsrc[128]), pack2(wsrc[256], wsrc[384]), 0u, 0u});
        bias[tt] = p.gla_b_gate[((size_t)L * 2 + dir) * 128 + h * 32 + tt * 16 + l15];
      }
    }
    const int ca0 = dir ? 12 - quad * 4 : quad * 4;
    u32x2 qraw[2], kraw[2], vraw[4]; float4 lowraw;
    auto load_step = [&](int n) {
      int t0 = dir ? S - 16 * (n + 1) : 16 * n;
      int rl = dir ? t0 + 15 - l15 : t0 + l15;
      qraw[0] = *(const u32x2*)(LQ + (size_t)rl * 128 + quad * 4);
      qraw[1] = *(const u32x2*)(LQ + (size_t)rl * 128 + 16 + quad * 4);
      kraw[0] = *(const u32x2*)(LK + (size_t)rl * 128 + quad * 4);
      kraw[1] = *(const u32x2*)(LK + (size_t)rl * 128 + 16 + quad * 4);
#pragma unroll
      for (int s = 0; s < 2; ++s) {
        vraw[2 * s] = *(const u32x2*)(LV + (size_t)rl * 256 + 32 * s + quad * 4);
        vraw[2 * s + 1] = *(const u32x2*)(LV + (size_t)rl * 256 + 32 * s + 16 + quad * 4);
      }
      lowraw = *(const float4*)(SM + (size_t)rl * 48 + quad * 4);
    };
#pragma unroll 1
    for (int half = 0; half < 2; ++half) {
      const int nbeg = half * (N >> 1), nend = nbeg + (N >> 1);
      load_step(nbeg);
      asm volatile("" ::: "memory");
#pragma unroll 1
      for (int n = nbeg; n < nend; ++n) {
        bf16x8 qn = __builtin_bit_cast(bf16x8, (u32x4){qraw[0].x, qraw[0].y, qraw[1].x, qraw[1].y});
        bf16x8 kn = __builtin_bit_cast(bf16x8, (u32x4){kraw[0].x, kraw[0].y, kraw[1].x, kraw[1].y});
        bf16x8 vn[2];
#pragma unroll
        for (int s = 0; s < 2; ++s) vn[s] = __builtin_bit_cast(bf16x8, (u32x4){vraw[2 * s].x, vraw[2 * s].y, vraw[2 * s + 1].x, vraw[2 * s + 1].y});
        bf16x8 lowA = __builtin_bit_cast(bf16x8, (u32x4){pack2(lowraw.x, lowraw.y), pack2(lowraw.z, lowraw.w), 0u, 0u});
        load_step(n + 1 < nend ? n + 1 : n);
        asm volatile("" : "+v"(qn), "+v"(kn), "+v"(lowA), "+v"(vn[0]), "+v"(vn[1]) :: "memory");
        f32x4 VC[4];
#pragma unroll
        for (int et = 0; et < 4; ++et) VC[et] = mfma16(vn[et >> 1], (et & 1) ? selO : selE, F4Z);
        f32x4 bC[2], bN[2];
#pragma unroll
        for (int t = 0; t < 2; ++t) {
          f32x4 g = mfma16(lowA, wupB[t], F4Z);
          f32x4 ghi, glo;
#pragma unroll
          for (int j = 0; j < 4; ++j) {
            g[j] = logsigmoidf(g[j] + bias[t]) * (1.f / 16.f);
            ghi[j] = bf2f(f2bf(g[j])); glo[j] = g[j] - ghi[j];
          }
          bN[t] = mfma16(pk4(ghi), triB, F4Z);
          bN[t] = mfma16(pk4(glo), triB, bN[t]);
          float p0 = g[0], p1 = p0 + g[1], p2 = p1 + g[2], p3 = p2 + g[3];
          float off = 0.f;
          float s1 = __shfl_up(p3, 16), s2 = __shfl_up(p3, 32), s3 = __shfl_up(p3, 48);
          if (quad >= 1) off += s1;
          if (quad >= 2) off += s2;
          if (quad >= 3) off += s3;
          bC[t] = (f32x4){p0 + off, p1 + off, p2 + off, p3 + off};
        }
        bf16x8 qe, ke;
        {
          u32x4 qu = __builtin_bit_cast(u32x4, qn), ku = __builtin_bit_cast(u32x4, kn);
          u32x4 qo, ko;
#pragma unroll
          for (int w = 0; w < 4; ++w) {
            float b0 = bN[w >> 1][(w & 1) * 2], b1 = bN[w >> 1][(w & 1) * 2 + 1];
            qo[w] = pack2(bf2f(qu[w] & 0xffff) * 0.17677669529663687f * fexp(b0), bf2f(qu[w] >> 16) * 0.17677669529663687f * fexp(b1));
            ko[w] = pack2(bf2f(ku[w] & 0xffff) * fexp(-b0), bf2f(ku[w] >> 16) * fexp(-b1));
          }
          qe = __builtin_bit_cast(bf16x8, qo); ke = __builtin_bit_cast(bf16x8, ko);
        }
        f32x4 AT = mfma16(ke, qe, F4Z);
#pragma unroll
        for (int j = 0; j < 4; ++j) AT[j] = (l15 >= quad * 4 + j) ? AT[j] : 0.f;
        const u32x4 aa = __builtin_bit_cast(u32x4, pk4(AT));
        f32x4 KC[2];
        KC[0] = mfma16(kn, selE, F4Z); KC[1] = mfma16(kn, selO, F4Z);
        u32x4 kdu[2]; f32x4 cdq[2];
#pragma unroll
        for (int dt = 0; dt < 2; ++dt) {
          const float blC = __shfl(bC[dt][3], 48 + l15);
          f32x4 kd;
#pragma unroll
          for (int j = 0; j < 4; ++j) {
            kd[j] = KC[dt][j] * fexp(blC - bC[dt][j]);
            cdq[dt][j] = fexp(__shfl(bN[dt][j], quad * 16 + 15));
          }
          kdu[dt] = __builtin_bit_cast(u32x4, pk4(kd));
        }
        u32x4 vcu[4];
#pragma unroll
        for (int et = 0; et < 4; ++et) vcu[et] = __builtin_bit_cast(u32x4, pk4(VC[et]));
        const int slot = n & (SCAN_R - 1);
        ring_wait(done + slot, n - SCAN_R + 1);
        asm volatile("" ::: "memory");
        u32x4* sp = slots + slot * SCAN_SLOT_V4 * 64;
        sp[0 * 64] = __builtin_bit_cast(u32x4, qe);
        sp[1 * 64] = (u32x4){aa.x, aa.y, kdu[0].x, kdu[0].y};
        sp[2 * 64] = (u32x4){kdu[1].x, kdu[1].y, vcu[0].x, vcu[0].y};
        sp[3 * 64] = (u32x4){vcu[1].x, vcu[1].y, vcu[2].x, vcu[2].y};
        sp[4 * 64] = (u32x4){vcu[3].x, vcu[3].y, 0u, 0u};
        sp[5 * 64] = __builtin_bit_cast(u32x4, cdq[0]);
        sp[6 * 64] = __builtin_bit_cast(u32x4, cdq[1]);
        asm volatile("s_waitcnt lgkmcnt(0)" ::: "memory");
        ready[slot] = n + 1;
        asm volatile("" ::: "memory");
      }
      __syncthreads();
    }
  } else {
    f32x4 St[2][4];
#pragma unroll
    for (int a2 = 0; a2 < 2; ++a2)
#pragma unroll
      for (int b2 = 0; b2 < 4; ++b2) St[a2][b2] = F4Z;
    u32x2 rpk[4] = {(u32x2){0u, 0u}, (u32x2){0u, 0u}, (u32x2){0u, 0u}, (u32x2){0u, 0u}};
    u16* prev_ptr = OUT + (size_t)(dir ? S - 1 - l15 : l15) * 256 + quad * 4;
#pragma unroll 1
    for (int half = 0; half < 2; ++half) {
      const int nbeg = half * (N >> 1), nend = nbeg + (N >> 1);
#pragma unroll 1
      for (int n = nbeg; n < nend; ++n) {
        const int t0 = dir ? S - 16 * (n + 1) : 16 * n;
#pragma unroll
        for (int et = 0; et < 4; ++et) *(u32x2*)(prev_ptr + et * 16) = rpk[et];
        {
          const size_t row = (size_t)(dir ? t0 + 15 - l15 : t0 + l15);
          prev_ptr = (half == 0 ? OUT : SLOT) + row * 256 + quad * 4;
        }
        const int slot = n & (SCAN_R - 1);
        ring_wait(ready + slot, n + 1);
        asm volatile("" ::: "memory");
        const u32x4* sp = slots + slot * SCAN_SLOT_V4 * 64;
        const u32x4 m0 = sp[0 * 64], m1 = sp[1 * 64], m2 = sp[2 * 64], m3 = sp[3 * 64], m4 = sp[4 * 64], m5 = sp[5 * 64], m6 = sp[6 * 64];
        asm volatile("s_waitcnt lgkmcnt(0)" ::: "memory");
        done[slot] = n + 1;
        asm volatile("" ::: "memory");
        const bf16x8 qe = __builtin_bit_cast(bf16x8, m0);
        const bf16x8 atp = __builtin_bit_cast(bf16x8, (u32x4){m1.x, m1.y, 0u, 0u});
        bf16x8 kdp[2], vcp[4];
        kdp[0] = __builtin_bit_cast(bf16x8, (u32x4){m1.z, m1.w, 0u, 0u}); kdp[1] = __builtin_bit_cast(bf16x8, (u32x4){m2.x, m2.y, 0u, 0u});
        vcp[0] = __builtin_bit_cast(bf16x8, (u32x4){m2.z, m2.w, 0u, 0u}); vcp[1] = __builtin_bit_cast(bf16x8, (u32x4){m3.x, m3.y, 0u, 0u});
        vcp[2] = __builtin_bit_cast(bf16x8, (u32x4){m3.z, m3.w, 0u, 0u}); vcp[3] = __builtin_bit_cast(bf16x8, (u32x4){m4.x, m4.y, 0u, 0u});
        f32x4 cdq[2]; cdq[0] = __builtin_bit_cast(f32x4, m5); cdq[1] = __builtin_bit_cast(f32x4, m6);
        f32x4 O[4];
#pragma unroll
        for (int et = 0; et < 4; ++et) {
          O[et] = mfma16(vcp[et], atp, F4Z);
          O[et] = mfma16(pk8(St[0][et], St[1][et]), qe, O[et]);
        }
#pragma unroll
        for (int dt = 0; dt < 2; ++dt)
#pragma unroll
          for (int et = 0; et < 4; ++et) {
            f32x4 c = St[dt][et];
#pragma unroll
            for (int j = 0; j < 4; ++j) c[j] *= cdq[dt][j];
            St[dt][et] = mfma16(kdp[dt], vcp[et], c);
          }
#pragma unroll
        for (int et = 0; et < 4; ++et) rpk[et] = (u32x2){pack2(O[et][0], O[et][1]), pack2(O[et][2], O[et][3])};
      }
#pragma unroll
      for (int et = 0; et < 4; ++et) *(u32x2*)(prev_ptr + et * 16) = rpk[et];
      __syncthreads();
    }
  }
  scan_combine(OUT, SLOT, 256, (const u16*)(p.ws + OFF_LGATE) + (size_t)sbase * 256 + h * 64, S, tid);
}

DI void scan_block(const Params& p, int L, int task, u16* smem) {
  __builtin_amdgcn_s_setprio(3);
  if (task < 96) dn_task(p, L, task >> 2, task & 3, smem); else gla_task(p, L, (task - 96) >> 2, task & 3, smem);
  __builtin_amdgcn_s_setprio(0);
}

#define N_SCAN_TASKS 192
#define N_MIX_TASKS (192 + 2048 + 2048)
DI void mix_task(const Params& p, int L, int task, u16* smem) {
  if (task < N_SCAN_TASKS) {
    scan_block(p, L, task, smem);
    return;
  }
  int u = task - N_SCAN_TASKS;
  if (u < 2048) {
    int seq, h, qb;
    if (u < 1024) { seq = u >> 7; h = (u >> 5) & 3; qb = u & 31; }
    else { u -= 1024; seq = 8 + (u >> 6); h = (u >> 4) & 3; qb = u & 15; }
    int sbase = seq_base(seq), S = seq_len(seq);
    int kvh = h >> 1;
    u16* Qp = (u16*)(p.ws + OFF_C0) + (size_t)(sbase + qb * 128) * 256 + h * 64;
    const u16* Kp = (const u16*)(p.ws + OFF_AK) + (size_t)sbase * 128 + kvh * 64;
    const u16* VTp = (const u16*)(p.ws + OFF_AVT) + (size_t)sbase * 128 + (size_t)kvh * 64 * S;
    const u16* Gp = (const u16*)(p.ws + OFF_AGATE) + (size_t)(sbase + qb * 128) * 256 + h * 64;
#ifndef NO_ATT
    attn_block(Qp, Kp, 128, VTp, S, Gp, smem);
#endif
  } else {
    u -= 2048;
    int qbg = u >> 2, h = u & 3;
    int tok0 = qbg * 128;
    int seq = seq_of_token(tok0);
    u16* Qp = (u16*)(p.ws + OFF_C3) + (size_t)tok0 * 256 + h * 64;
    const u16* Kp = (const u16*)(p.ws + OFF_KM) + (size_t)seq * 256 * 256 + h * 64;
    const u16* VTp = (const u16*)(p.ws + OFF_VMT) + ((size_t)seq * 4 + h) * 64 * 256;
    const u16* Gp = (const u16*)(p.ws + OFF_MGATE) + (size_t)tok0 * 256 + h * 64;
#ifndef NO_ATT
    attn_block(Qp, Kp, 256, VTp, 256, Gp, smem);
#endif
  }
}

DI void phase_final(const Params& p, int gtid, int gthreads) {
  int wid = gtid >> 6, nw = gthreads >> 6, lane = gtid & 63;
  const float* HF = (const float*)(p.ws + OFF_HFINAL);
  const float* SUMSQ = (const float*)(p.ws + OFF_SUMSQ);
  float4 g[4];
#pragma unroll
  for (int i = 0; i < 4; ++i) g[i] = *(const float4*)(p.final_norm_g + i * 256 + lane * 4);
  for (int t0 = wid; t0 < T_TOK; t0 += 2 * nw) {
    float4 v[2][4]; float ssq[2];
#pragma unroll
    for (int u = 0; u < 2; ++u) {
      const int t = t0 + u * nw < T_TOK ? t0 + u * nw : t0;
      ssq[u] = lane < 16 ? SUMSQ[(size_t)t * 16 + lane] : 0.f;
#pragma unroll
      for (int i = 0; i < 4; ++i) v[u][i] = *(const float4*)(HF + (size_t)t * 1024 + i * 256 + lane * 4);
    }
#pragma unroll
    for (int u = 0; u < 2; ++u) {
      const int t = t0 + u * nw;
      if (t < T_TOK) {
        const float r = rsqrtf(wave_sum(ssq[u]) * (1.f / 1024.f) + EPSF);
#pragma unroll
        for (int i = 0; i < 4; ++i) {
          const float4 a = v[u][i];
          *(float4*)(p.out + (size_t)t * 1024 + i * 256 + lane * 4) = make_float4(a.x * r * g[i].x, a.y * r * g[i].y, a.z * r * g[i].z, a.w * r * g[i].w);
        }
      }
    }
  }
}

#define XB_TMO      128
#define XB_XCNT(j)  (256  + 64 * (j))
#define XB_XSUB(j)  (1280 + 64 * (j))
#define XB_XGEN(j)  (2304 + 64 * (j))
#define XB_TOP      3328
#define XB_TOPGEN   3392
#define XCD_BAR_WORDS 3456
#define XB_SPIN_CAP (1u << 18)
#define LAS __attribute__((address_space(3)))

__device__ __forceinline__ unsigned xb_ld(unsigned* p)              { return __hip_atomic_load(p, __ATOMIC_RELAXED, __HIP_MEMORY_SCOPE_AGENT); }
__device__ __forceinline__ unsigned xb_add(unsigned* p, unsigned v) { return __hip_atomic_fetch_add(p, v, __ATOMIC_RELAXED, __HIP_MEMORY_SCOPE_AGENT); }
__device__ __forceinline__ unsigned xb_xcc_id() { return (unsigned)__builtin_amdgcn_s_getreg((3 << 11) | 20) & 0xFu; }
#define XB_SPIN(cond, bar) do { unsigned _sp = 0; while (cond) { __builtin_amdgcn_s_sleep(1); \
    if ((++_sp & 255u) == 0u) { if (xb_ld(&(bar)[XB_TMO])) break; if (_sp > XB_SPIN_CAP) { atomicAdd(&(bar)[XB_TMO], 1u); break; } } } } while (0)

struct XcdBarrier {
    unsigned* bar; unsigned x;
    volatile LAS unsigned* st;
};

__device__ __forceinline__ XcdBarrier xcd_barrier_post(unsigned* bar, volatile LAS unsigned* st) {
    XcdBarrier b; b.bar = bar; b.x = xb_xcc_id(); b.st = st;
    if (threadIdx.x == 0) (void)xb_add(&bar[XB_XCNT(b.x)], 1u);
    return b;
}
__device__ __forceinline__ void xcd_barrier_complete(unsigned* bar, unsigned x, unsigned& nloc, unsigned& nx) {
    const unsigned G = gridDim.x * gridDim.y * gridDim.z;
    unsigned sum, cnt, mine, sp = 0u;
    for (;;) {
        sum = 0u; cnt = 0u; mine = 0u;
#pragma unroll
        for (unsigned j = 0; j < 16; ++j) { const unsigned c = xb_ld(&bar[XB_XCNT(j)]); sum += c; cnt += (c > 0u) ? 1u : 0u; mine = (j == x) ? c : mine; }
        if (sum == G) break;
        __builtin_amdgcn_s_sleep(1);
        if ((++sp & 255u) == 0u) { if (xb_ld(&bar[XB_TMO])) break; if (sp > XB_SPIN_CAP) { atomicAdd(&bar[XB_TMO], 1u); break; } }
    }
    nloc = mine > 0u ? mine : 1u; nx = cnt > 0u ? cnt : 1u;
}

__device__ __forceinline__ void xcd_barrier(const XcdBarrier& b) {
    asm volatile("s_waitcnt vmcnt(0)" ::: "memory");
    __syncthreads();
    if (threadIdx.x == 0) {
        unsigned* bar = b.bar;
        __builtin_amdgcn_s_waitcnt(0);
        unsigned nloc = b.st[0], nx = b.st[1];
        if (nloc == 0u) { xcd_barrier_complete(bar, b.x, nloc, nx); b.st[0] = nloc; b.st[1] = nx; }
        const unsigned old = xb_add(&bar[XB_XSUB(b.x)], 1u);
        const unsigned gen = old / nloc;
        if (old + 1u == (gen + 1u) * nloc) {
            __builtin_amdgcn_fence(__ATOMIC_RELEASE, "agent");
            asm volatile("s_waitcnt vmcnt(0)" ::: "memory");
            const unsigned og = xb_add(&bar[XB_TOP], 1u);
            const unsigned tg = og / nx;
            if (og + 1u == (tg + 1u) * nx) xb_add(&bar[XB_TOPGEN], 1u);
            else XB_SPIN(xb_ld(&bar[XB_TOPGEN]) == tg, bar);
            __builtin_amdgcn_fence(__ATOMIC_ACQUIRE, "agent");
            xb_add(&bar[XB_XGEN(b.x)], 1u);
            asm volatile("s_waitcnt vmcnt(0)" ::: "memory");
        } else {
            XB_SPIN(xb_ld(&bar[XB_XGEN(b.x)]) == gen, bar);
            __builtin_amdgcn_fence(__ATOMIC_ACQUIRE, "agent");
            asm volatile("s_waitcnt vmcnt(0)" ::: "memory");
        }
    }
    __syncthreads();
}


#define N_PHASES 18
#ifndef LB_MIN
#define LB_MIN 2
#endif
#define SMEM_BYTES (384 * LDS_STRIDE * 2 + 1024)

template <bool COOP>
__global__ void __launch_bounds__(256, LB_MIN) mega(Params p, int ph_lo, int ph_hi) {
  extern __shared__ __attribute__((aligned(16))) unsigned char smem_raw[];
  __shared__ int s_task;
  __shared__ int s_elig;
  __shared__ uint4 xb_words;
  u16* smem = (u16*)smem_raw;
  const int gthreads = gridDim.x * 256;
  XcdBarrier xb;
  if (COOP) {
    if (threadIdx.x == 0) xb_words = make_uint4(0u, 0u, 0u, 0u);
    __syncthreads();
    xb = xcd_barrier_post((unsigned*)(p.ws + OFF_XBAR), (volatile LAS unsigned*)&xb_words);
  }
  for (int ph = ph_lo; ph < ph_hi; ++ph) {
    const int gtid = blockIdx.x * 256 + otid();
    if (ph == 0) {
#ifndef NO_P0
      phase_prep(p, gtid, gthreads);
#endif
    } else if (ph == N_PHASES - 1) {
#ifndef NO_FIN
      phase_final(p, gtid, gthreads);
#endif
    } else {
      int L = (ph - 1) / 4, sub = (ph - 1) % 4;
      if (sub == 0) {
        for (int t = blockIdx.x; t < 13 * 512 + 96; t += gridDim.x) {
#ifndef NO_G1
          if (t < 13 * 512) g1_tile(p, L, t, smem);
#endif
#ifndef NO_G3
          if (t >= 13 * 512) g3_tile(p, L, t - 13 * 512, smem);
#endif
        }
      } else if (sub == 1) {
#ifndef NO_PREP
        for (int t = blockIdx.x; t < 2048; t += gridDim.x) {
          const int xcd = t & 7, j = ((t & 511) >> 3) + 64 * (t >> 9);
          prep_task(p, L, (xcd * 64 + (j >> 2)) * 4 + (j & 3), smem);
        }
#endif
      } else if (sub == 2) {
        int* cnt_scan = (int*)(p.ws + OFF_CNT) + L;
        int* cnt_att = (int*)(p.ws + OFF_CNT) + 4 + L;
        __syncthreads();
        if (threadIdx.x == 0) {
          unsigned xcc = __builtin_amdgcn_s_getreg((3 << 11) | (0 << 6) | 20);
          unsigned hw = __builtin_amdgcn_s_getreg((15 << 11) | (0 << 6) | 4);
          unsigned cu = (hw >> 8) & 0xf, sh = (hw >> 12) & 1, se = (hw >> 13) & 7;
          unsigned cuid = (((xcc & 15) * 8 + se) * 2 + sh) * 16 + cu;
          s_elig = atomicCAS((int*)(p.ws + OFF_CUFLAG) + L * 4096 + cuid, 0, 1) == 0 ? 1 : 0;
        }
        while (true) {
          __syncthreads();
          if (threadIdx.x == 0) {
            int task = -1;
            if (s_elig) { int t = atomicAdd(cnt_scan, 1); if (t < N_SCAN_TASKS) task = t; else s_elig = 0; }
            if (task < 0) { int t = atomicAdd(cnt_att, 1); task = t < (N_MIX_TASKS - N_SCAN_TASKS) ? N_SCAN_TASKS + t : N_MIX_TASKS; }
            s_task = task;
          }
          __syncthreads();
          int task = s_task;
          if (task >= N_MIX_TASKS) break;
          mix_task(p, L, task, smem);
        }
      } else {
#ifndef NO_G2
        for (int t = blockIdx.x; t < 2048; t += gridDim.x) g2_tile(p, L, t, smem);
#endif
      }
    }
    if (COOP && ph + 1 < ph_hi) {
      if (ph == 0) cg::this_grid().sync();
      else xcd_barrier(xb);
    }
  }
}

extern "C" void kernel_launch(void* const* d_in, const int* in_sizes, int n_in, void* d_out, int out_size,
                              void* d_ws, size_t ws_size, hipStream_t stream) {
  if (ws_size < WS_NEED) { fprintf(stderr, "ws too small: %zu < %zu\n", ws_size, (size_t)WS_NEED); return; }
  Params p{};
  const float** pp = (const float**)&p;
  for (int i = 0; i < 19; ++i) pp[i] = (const float*)d_in[i];
  p.out = (float*)d_out; p.ws = (unsigned char*)d_ws;
  (void)hipMemsetAsync((unsigned char*)d_ws + OFF_CNT, 0, 256 + 4 * 4096 * 4 + 3456 * 4, stream);
  static int grid_blocks = 0;
  if (!grid_blocks) {
    int dev = 0, cus = 0, per_cu = 0;
    (void)hipGetDevice(&dev);
    (void)hipDeviceGetAttribute(&cus, hipDeviceAttributeMultiprocessorCount, dev);
    (void)hipFuncSetAttribute((const void*)mega<true>, hipFuncAttributeMaxDynamicSharedMemorySize, SMEM_BYTES);
    (void)hipOccupancyMaxActiveBlocksPerMultiprocessor(&per_cu, mega<true>, 256, SMEM_BYTES);
    if (per_cu < 1) per_cu = 1;
    if (per_cu > 2) per_cu = 2;
    grid_blocks = cus * per_cu;
  }
  int ph_lo = 0, ph_hi = N_PHASES;
  void* args[] = {&p, &ph_lo, &ph_hi};
  hipError_t e = hipLaunchCooperativeKernel((void*)mega<true>, dim3(grid_blocks), dim3(256), args, SMEM_BYTES, stream);
  if (e != hipSuccess) fprintf(stderr, "cooperative launch failed: %s (grid %d)\n", hipGetErrorString(e), grid_blocks);
}
```

```cpp
#include <hip/hip_runtime.h>
#include <hip/hip_cooperative_groups.h>
#include <stdint.h>
#include <stdio.h>
namespace cg = cooperative_groups;

typedef __attribute__((ext_vector_type(8))) short bf16x8;
typedef __attribute__((ext_vector_type(4))) float f32x4;
typedef unsigned short u16;
typedef __attribute__((ext_vector_type(4))) unsigned int u32x4;
typedef __attribute__((ext_vector_type(2))) unsigned int u32x2;

#define DI __device__ __forceinline__
#define T_TOK 65536
#define DM 1024
#define NPAD 3200
#define NIN 3120
#define EPSF 1e-6f
#define LDS_STRIDE 72

static constexpr size_t SZ_C = (size_t)T_TOK * 256 * 2;
static constexpr size_t OFF_C0 = 0;
static constexpr size_t OFF_C1 = OFF_C0 + SZ_C;
static constexpr size_t OFF_C2 = OFF_C1 + SZ_C;
static constexpr size_t OFF_C3 = OFF_C2 + SZ_C;
static constexpr size_t OFF_AK = OFF_C3 + SZ_C;
static constexpr size_t OFF_AVT = OFF_AK + SZ_C / 2;
static constexpr size_t OFF_AGATE = OFF_AVT + SZ_C / 2;
static constexpr size_t OFF_DGATE = OFF_AGATE + SZ_C;
static constexpr size_t OFF_LGATE = OFF_DGATE + SZ_C;
static constexpr size_t OFF_MGATE = OFF_LGATE + SZ_C;
static constexpr size_t OFF_DQKV = OFF_MGATE + SZ_C;
static constexpr size_t OFF_LQ = OFF_DQKV + 3 * SZ_C;
static constexpr size_t OFF_LK = OFF_LQ + SZ_C / 2;
static constexpr size_t OFF_LV = OFF_LK + SZ_C / 2;
static constexpr size_t OFF_HFINAL = OFF_AK;
static constexpr size_t OFF_SMALL = OFF_LV + SZ_C;
static constexpr size_t OFF_SUMSQ = OFF_SMALL + (size_t)T_TOK * 48 * 4;
static constexpr size_t OFF_WIN = OFF_SUMSQ + (size_t)T_TOK * 16 * 4;
static constexpr size_t OFF_WOUT = OFF_WIN + (size_t)4 * NPAD * 1024 * 2;
static constexpr size_t OFF_WMKV = OFF_WOUT + (size_t)4 * 1024 * 1024 * 2;
static constexpr size_t OFF_KM = OFF_WMKV + (size_t)4 * 512 * 1024 * 2;
static constexpr size_t OFF_VMT = OFF_KM + (size_t)6144 * 256 * 2;
static constexpr size_t OFF_MEMRSTD = OFF_VMT + (size_t)6144 * 256 * 2;
static constexpr size_t OFF_ROPE = OFF_MEMRSTD + 6144 * 4;
static constexpr size_t OFF_HALO = OFF_ROPE + 2 * 64 * 16 * 4;
static constexpr size_t OFF_CNT = OFF_HALO + (size_t)512 * 2 * 768 * 2;
static constexpr size_t OFF_CUFLAG = OFF_CNT + 256;
static constexpr size_t OFF_XBAR = OFF_CUFLAG + 4 * 4096 * 4;
static constexpr size_t WS_NEED = OFF_XBAR + 3456 * 4;
static_assert(OFF_HFINAL + (size_t)T_TOK * 1024 * 4 <= OFF_SMALL, "hfinal alias");
static_assert(WS_NEED <= (size_t)536870912, "ws budget");

struct Params {
  const float* x_prompt; const float* x_sample; const float* mem_prompt; const float* mem_sample;
  const float* norm_g; const float* w_in; const float* att_q_norm_g; const float* att_k_norm_g;
  const float* gdn_conv_w; const float* gdn_a_log; const float* gdn_dt_bias; const float* gdn_out_norm_g;
  const float* gla_w_gate_up; const float* gla_b_gate; const float* gla_out_norm_g; const float* mem_norm_g;
  const float* w_mem_kv; const float* w_out; const float* final_norm_g;
  float* out; unsigned char* ws;
};

DI u16 f2bf(float f) { uint32_t u = __float_as_uint(f); u += 0x7fffu + ((u >> 16) & 1u); return (u16)(u >> 16); }
DI float bf2f(u16 h) { return __uint_as_float(((uint32_t)h) << 16); }
typedef __attribute__((ext_vector_type(2))) float f32x2_t;
typedef __attribute__((ext_vector_type(2))) __bf16 bf16x2_t;
DI uint32_t pack2(float a, float b) { f32x2_t v = {a, b}; return __builtin_bit_cast(uint32_t, __builtin_convertvector(v, bf16x2_t)); }
DI float fast_exp2(float x) { float r; asm("v_exp_f32 %0, %1\n\ts_nop 1" : "=v"(r) : "v"(x)); return r; }
DI float fast_log2(float x) { float r; asm("v_log_f32 %0, %1\n\ts_nop 1" : "=v"(r) : "v"(x)); return r; }
DI float fexp(float x) { return fast_exp2(x * 1.4426950408889634f); }
DI float flog(float x) { return fast_log2(x) * 0.6931471805599453f; }
DI float siluf(float x) { return x / (1.f + fexp(-x)); }
DI float wave_sum(float v) {
#pragma unroll
  for (int o = 32; o >= 1; o >>= 1) v += __shfl_xor(v, o);
  return v;
}
DI int seq_of_token(int t) { return t < 32768 ? (t >> 12) : 8 + ((t - 32768) >> 11); }
DI int seq_base(int s) { return s < 8 ? s * 4096 : 32768 + (s - 8) * 2048; }
DI int seq_len(int s) { return s < 8 ? 4096 : 2048; }
DI int otid() { int t = threadIdx.x; asm volatile("" : "+v"(t)); return t; }
DI f32x4 mfma16(bf16x8 a, bf16x8 b, f32x4 c) { return __builtin_amdgcn_mfma_f32_16x16x32_bf16(a, b, c, 0, 0, 0); }

DI int win_orig_col(int n) {
  if (n < 768) return n;
  if (n < 1536) return n;
  if (n < 1792) return n - 1536 + 1552;
  if (n < 1920) return n - 1792 + 1808;
  if (n < 2048) return n - 1920 + 1936;
  if (n < 2304) return n - 2048 + 2064;
  if (n < 2560) return n - 2304 + 2352;
  if (n < 2816) return n - 2560 + 2608;
  if (n < 3072) return n - 2816 + 2864;
  if (n < 3080) return n - 3072 + 1536;
  if (n < 3088) return n - 3080 + 1544;
  return n - 3088 + 2320;
}

DI void phase_prep(const Params& p, int gtid, int gthreads) {
  u16* WIN = (u16*)(p.ws + OFF_WIN);
  u16* WOUT = (u16*)(p.ws + OFF_WOUT);
  u16* WMKV = (u16*)(p.ws + OFF_WMKV);
  for (int it = gtid; it < 4 * 128 * NPAD; it += gthreads) {
    int n = it % NPAD; int r = it / NPAD; int kc = r & 127; int L = r >> 7;
    uint32_t o[4] = {0, 0, 0, 0};
    if (n < NIN) {
      int oc = win_orig_col(n);
      const float* src = p.w_in + ((size_t)L * 1024 + kc * 8) * NIN + oc;
      const float* g = p.norm_g + L * 1024 + kc * 8;
      float v[8];
#pragma unroll
      for (int j = 0; j < 8; ++j) v[j] = src[(size_t)j * NIN] * g[j];
#pragma unroll
      for (int j = 0; j < 4; ++j) o[j] = pack2(v[2 * j], v[2 * j + 1]);
    }
    *(uint4*)(WIN + ((size_t)L * NPAD + n) * 1024 + kc * 8) = make_uint4(o[0], o[1], o[2], o[3]);
  }
  for (int it = gtid; it < 4 * 128 * 1024; it += gthreads) {
    int n = it & 1023; int r = it >> 10; int kc = r & 127; int L = r >> 7;
    const float* src = p.w_out + ((size_t)L * 1024 + kc * 8) * 1024 + n;
    uint32_t o[4];
#pragma unroll
    for (int j = 0; j < 4; ++j) o[j] = pack2(src[(size_t)(2 * j) * 1024], src[(size_t)(2 * j + 1) * 1024]);
    *(uint4*)(WOUT + ((size_t)L * 1024 + n) * 1024 + kc * 8) = make_uint4(o[0], o[1], o[2], o[3]);
  }
  for (int it = gtid; it < 4 * 128 * 512; it += gthreads) {
    int n = it & 511; int r = it >> 9; int kc = r & 127; int L = r >> 7;
    const float* src = p.w_mem_kv + ((size_t)L * 1024 + kc * 8) * 512 + n;
    const float* g = p.mem_norm_g + L * 1024 + kc * 8;
    uint32_t o[4];
#pragma unroll
    for (int j = 0; j < 4; ++j) o[j] = pack2(src[(size_t)(2 * j) * 512] * g[2 * j], src[(size_t)(2 * j + 1) * 512] * g[2 * j + 1]);
    *(uint4*)(WMKV + ((size_t)L * 512 + n) * 1024 + kc * 8) = make_uint4(o[0], o[1], o[2], o[3]);
  }
  float* rope = (float*)(p.ws + OFF_ROPE);
  for (int it = gtid; it < 1024; it += gthreads) {
    int pos = it >> 4, i = it & 15;
    float inv = exp2f(-(float)i * (13.287712379549449f / 16.f));
    float a = (float)pos * inv;
    rope[it] = __cosf(a); rope[1024 + it] = __sinf(a);
  }
  int wid = gtid >> 6, nw = gthreads >> 6, lane = gtid & 63;
  u16* HI = (u16*)p.out; u16* LO = HI + (size_t)T_TOK * 1024;
  float* SUMSQ = (float*)(p.ws + OFF_SUMSQ);
  for (int t0 = wid; t0 < T_TOK; t0 += 2 * nw) {
    float4 v[2][4];
#pragma unroll
    for (int u = 0; u < 2; ++u) {
      const int t = t0 + u * nw < T_TOK ? t0 + u * nw : t0;
      const float* src = t < 32768 ? p.x_prompt + (size_t)t * 1024 : p.x_sample + (size_t)(t - 32768) * 1024;
#pragma unroll
      for (int i = 0; i < 4; ++i) v[u][i] = *(const float4*)(src + i * 256 + lane * 4);
    }
#pragma unroll
    for (int u = 0; u < 2; ++u) {
      const int t = t0 + u * nw;
      if (t < T_TOK) {
        float ss = 0.f;
#pragma unroll
        for (int i = 0; i < 4; ++i) {
          const float4 a = v[u][i];
          ss += a.x * a.x + a.y * a.y + a.z * a.z + a.w * a.w;
          *(uint2*)(HI + (size_t)t * 1024 + i * 256 + lane * 4) = make_uint2(pack2(a.x, a.y), pack2(a.z, a.w));
        }
        ss += __shfl_xor(ss, 1); ss += __shfl_xor(ss, 2);
        if ((lane & 3) == 0) SUMSQ[(size_t)t * 16 + (lane >> 2)] = ss;
      }
    }
  }
  float* MEMRSTD = (float*)(p.ws + OFF_MEMRSTD);
  for (int r = wid; r < 6144; r += nw) {
    const float* src = r < 2048 ? p.mem_prompt + (size_t)r * 1024 : p.mem_sample + (size_t)(r - 2048) * 1024;
    float ss = 0.f;
#pragma unroll
    for (int i = 0; i < 4; ++i) { float4 v = *(const float4*)(src + i * 256 + lane * 4); ss += v.x * v.x + v.y * v.y + v.z * v.z + v.w * v.w; }
    ss = wave_sum(ss);
    if (lane == 0) MEMRSTD[r] = rsqrtf(ss * (1.f / 1024.f) + EPSF);
  }
}

struct QSrc { const void* base; int ldq; const u16* c0; const u16* c1; const u16* c2; const u16* c3; };

#define QT 8
#define TM 256
template <int QMODE>
DI void gemm_load(u32x4 (&pr)[4], u32x4 (&qr)[8], const u16* W, const QSrc& q, int m0, int k0, int tid) {
  const int row0 = tid >> 3, kc = tid & 7;
  const u16* wp = W + (size_t)row0 * 1024 + k0 + kc * 8;
#pragma unroll
  for (int i = 0; i < 4; ++i) pr[i] = *(const u32x4*)(wp + (size_t)i * 32 * 1024);
  if (QMODE == 0) {
    const u16* qp = (const u16*)q.base + (size_t)(m0 + row0) * 1024 + k0 + kc * 8;
#pragma unroll
    for (int i = 0; i < 8; ++i) qr[i] = *(const u32x4*)(qp + (size_t)i * 32 * 1024);
  } else if (QMODE == 1) {
    const float* s = (const float*)q.base + (size_t)(m0 + row0) * 1024 + k0 + kc * 8;
#pragma unroll
    for (int i = 0; i < 8; ++i) {
      float4 a = *(const float4*)(s + (size_t)i * 32 * 1024), b = *(const float4*)(s + (size_t)i * 32 * 1024 + 4);
      qr[i] = (u32x4){pack2(a.x, a.y), pack2(a.z, a.w), pack2(b.x, b.y), pack2(b.z, b.w)};
    }
  } else {
    const int rg = k0 >> 8;
    const u16* cb = q.c0 + (size_t)rg * ((size_t)T_TOK * 256);
    const u16* s = cb + (size_t)(m0 + row0) * 256 + (k0 & 255) + kc * 8;
#pragma unroll
    for (int i = 0; i < 8; ++i) qr[i] = *(const u32x4*)(s + (size_t)i * 32 * 256);
  }
}

template <int QMODE>
DI void gemm_core(f32x4 (&acc)[4][QT], const u16* W  , const QSrc& q, int m0, u16* smem) {
  const int tid = otid(), lane = tid & 63, wave = tid >> 6;
  const int wn = wave & 1, wq = wave >> 1, l15 = lane & 15, quad = lane >> 4;
  u16* Ps = smem; u16* Qs = smem + 128 * LDS_STRIDE;
#pragma unroll
  for (int a = 0; a < 4; ++a)
#pragma unroll
    for (int b = 0; b < QT; ++b) acc[a][b] = (f32x4){0.f, 0.f, 0.f, 0.f};
  u32x4 pr[4], qr[8];
  gemm_load<QMODE>(pr, qr, W, q, m0, 0, tid);
#pragma unroll 1
  for (int kt = 0; kt < 16; ++kt) {
    __syncthreads();
    {
      u16* wb = Ps + (tid >> 3) * LDS_STRIDE + (tid & 7) * 8;
#pragma unroll
      for (int i = 0; i < 4; ++i) *(u32x4*)(wb + i * 32 * LDS_STRIDE) = pr[i];
#pragma unroll
      for (int i = 0; i < 8; ++i) *(u32x4*)(wb + (128 + i * 32) * LDS_STRIDE) = qr[i];
    }
    __syncthreads();
    if (kt + 1 < 16) gemm_load<QMODE>(pr, qr, W, q, m0, (kt + 1) * 64, tid);
#pragma unroll
    for (int ks = 0; ks < 2; ++ks) {
      bf16x8 pf[4];
#pragma unroll
      for (int i = 0; i < 4; ++i) pf[i] = *(const bf16x8*)(Ps + (wn * 64 + i * 16 + l15) * LDS_STRIDE + ks * 32 + quad * 8);
#pragma unroll
      for (int hb = 0; hb < 2; ++hb) {
        bf16x8 qf[4];
#pragma unroll
        for (int i = 0; i < 4; ++i) qf[i] = *(const bf16x8*)(Qs + (wq * 128 + (hb * 4 + i) * 16 + l15) * LDS_STRIDE + ks * 32 + quad * 8);
        __builtin_amdgcn_sched_barrier(0);
#pragma unroll
        for (int a = 0; a < 4; ++a)
#pragma unroll
          for (int b = 0; b < 4; ++b) acc[a][hb * 4 + b] = mfma16(pf[a], qf[b], acc[a][hb * 4 + b]);
        __builtin_amdgcn_sched_barrier(0);
      }
    }
  }
}

DI void g1_tile(const Params& p, int L, int tile, u16* smem) {
  int mt, nt;
  {
    const int xcd = tile & 7, lb = (tile & 511) >> 3, rnd = tile >> 9;
    const int j = lb + 64 * rnd;
    if (j >= 800) return;
    const int mg = j / 100, r = j % 100;
    int mi;
    if (r < 64) { mi = r & 3; nt = r >> 2; } else { const int rr = r - 64; mi = rr & 3; nt = 16 + (rr >> 2); }
    mt = xcd * 32 + mg * 4 + mi;
  }
  const int m0 = mt * TM, n0 = nt * 128;
  const int tid = otid(), lane = tid & 63, wave = tid >> 6;
  const int wn = wave & 1, wq = wave >> 1, l15 = lane & 15, quad = lane >> 4;
  float* rstd_s = (float*)(smem + 384 * LDS_STRIDE);
  __syncthreads();
  {
    const float4* s = (const float4*)((const float*)(p.ws + OFF_SUMSQ) + (size_t)(m0 + tid) * 16);
    float4 a = s[0], b = s[1], c = s[2], d = s[3];
    float ss = a.x + a.y + a.z + a.w + b.x + b.y + b.z + b.w + c.x + c.y + c.z + c.w + d.x + d.y + d.z + d.w;
    rstd_s[tid] = rsqrtf(ss * (1.f / 1024.f) + EPSF);
  }
  f32x4 acc[4][QT];
  QSrc q; q.base = p.out; q.ldq = 1024;
  const u16* W = (const u16*)(p.ws + OFF_WIN) + ((size_t)L * NPAD + n0) * 1024;
  gemm_core<0>(acc, W, q, m0, smem);
  float rs[QT];
#pragma unroll
  for (int qt = 0; qt < QT; ++qt) rs[qt] = rstd_s[wq * 128 + qt * 16 + l15];
#pragma unroll
  for (int a = 0; a < 4; ++a)
#pragma unroll
    for (int b = 0; b < QT; ++b)
#pragma unroll
      for (int j = 0; j < 4; ++j) acc[a][b][j] *= rs[b];
  const int seq = seq_of_token(m0), sbase = seq_base(seq), slen = seq_len(seq);
  if (nt <= 2) {
    const float* g = (nt <= 1 ? p.att_q_norm_g : p.att_k_norm_g) + L * 64;
    const float* rope = (const float*)(p.ws + OFF_ROPE);
    const float qscale = nt <= 1 ? 0.125f * 1.4426950408889634f : 1.f;
    u16* dst = nt <= 1 ? (u16*)(p.ws + OFF_C0) : (u16*)(p.ws + OFF_AK);
    const int dstride = nt <= 1 ? 256 : 128;
    const int colbase = (nt <= 1 ? nt * 128 : 0) + wn * 64;
#pragma unroll
    for (int qt = 0; qt < QT; ++qt) {
      int token = m0 + wq * 128 + qt * 16 + l15;
      int tpos = token - sbase;
      int prow = tpos >> 6, pcol = tpos & 63;
      float ss = 0.f;
#pragma unroll
      for (int pt = 0; pt < 4; ++pt)
#pragma unroll
        for (int j = 0; j < 4; ++j) ss += acc[pt][qt][j] * acc[pt][qt][j];
      ss += __shfl_xor(ss, 16); ss += __shfl_xor(ss, 32);
      float r = rsqrtf(ss * (1.f / 64.f) + EPSF);
      float v[4][4];
#pragma unroll
      for (int pt = 0; pt < 4; ++pt)
#pragma unroll
        for (int j = 0; j < 4; ++j) v[pt][j] = acc[pt][qt][j] * r * g[pt * 16 + quad * 4 + j];
#pragma unroll
      for (int ax = 0; ax < 2; ++ax) {
        int pos = ax == 0 ? prow : pcol;
#pragma unroll
        for (int j = 0; j < 4; ++j) {
          float c = rope[pos * 16 + quad * 4 + j], s = rope[1024 + pos * 16 + quad * 4 + j];
          float x1 = v[2 * ax][j], x2 = v[2 * ax + 1][j];
          v[2 * ax][j] = (x1 * c - x2 * s) * qscale;
          v[2 * ax + 1][j] = (x2 * c + x1 * s) * qscale;
        }
      }
#pragma unroll
      for (int pt = 0; pt < 4; ++pt)
        *(uint2*)(dst + (size_t)token * dstride + colbase + pt * 16 + quad * 4) = make_uint2(pack2(v[pt][0], v[pt][1]), pack2(v[pt][2], v[pt][3]));
    }
  } else if (nt == 3) {
    u16* AVT = (u16*)(p.ws + OFF_AVT) + (size_t)sbase * 128;
#pragma unroll
    for (int qt = 0; qt < QT; ++qt) {
      int tpos = m0 + wq * 128 + qt * 16 + l15 - sbase;
#pragma unroll
      for (int pt = 0; pt < 4; ++pt)
#pragma unroll
        for (int j = 0; j < 4; ++j) {
          int n = wn * 64 + pt * 16 + quad * 4 + j;
          AVT[(size_t)n * slen + tpos] = f2bf(acc[pt][qt][j]);
        }
    }
  } else if (nt == 24) {
    float* SMALL = (float*)(p.ws + OFF_SMALL);
    if (wn == 0) {
#pragma unroll
      for (int qt = 0; qt < QT; ++qt) {
        int token = m0 + wq * 128 + qt * 16 + l15;
#pragma unroll
        for (int pt = 0; pt < 3; ++pt)
          *(float4*)(SMALL + (size_t)token * 48 + pt * 16 + quad * 4) = make_float4(acc[pt][qt][0], acc[pt][qt][1], acc[pt][qt][2], acc[pt][qt][3]);
      }
    }
  } else {
    u16* dst; int dstride, colbase; int mode = 0;
    const float* gvec = nullptr;
    if (nt <= 5) { dst = (u16*)(p.ws + OFF_AGATE); dstride = 256; colbase = (nt - 4) * 128; mode = 1; }
    else if (nt <= 11) { dst = (u16*)(p.ws + OFF_DQKV); dstride = 768; colbase = (nt - 6) * 128; }
    else if (nt <= 13) { dst = (u16*)(p.ws + OFF_DGATE); dstride = 256; colbase = (nt - 12) * 128; mode = 1; gvec = p.gdn_out_norm_g + L * 64; }
    else if (nt == 14) { dst = (u16*)(p.ws + OFF_LQ); dstride = 128; colbase = 0; }
    else if (nt == 15) { dst = (u16*)(p.ws + OFF_LK); dstride = 128; colbase = 0; }
    else if (nt <= 17) { dst = (u16*)(p.ws + OFF_LV); dstride = 256; colbase = (nt - 16) * 128; }
    else if (nt <= 19) { dst = (u16*)(p.ws + OFF_LGATE); dstride = 256; colbase = (nt - 18) * 128; mode = 1; gvec = p.gla_out_norm_g + L * 64; }
    else if (nt <= 21) { dst = (u16*)(p.ws + OFF_C3); dstride = 256; colbase = (nt - 20) * 128; mode = 2; }
    else { dst = (u16*)(p.ws + OFF_MGATE); dstride = 256; colbase = (nt - 22) * 128; mode = 1; }
    u16* bp = dst + (size_t)(m0 + wq * 128 + l15) * dstride + colbase + wn * 64 + quad * 4;
    const bool is_dqkv = (nt >= 6 && nt <= 11);
    u16* halo = (u16*)(p.ws + OFF_HALO) + (size_t)(mt * 2 + wq) * 2 * 768 + colbase + wn * 64 + quad * 4;
#pragma unroll
    for (int qt = 0; qt < QT; ++qt) {
      u16* rp = bp + (size_t)(qt * 16) * dstride;
#pragma unroll
      for (int pt = 0; pt < 4; ++pt) {
        float v[4];
#pragma unroll
        for (int j = 0; j < 4; ++j) {
          float x = acc[pt][qt][j];
          v[j] = mode == 1 ? siluf(x) : (mode == 2 ? x * (0.125f * 1.4426950408889634f) : x);
        }
        if (gvec) {
          float4 gg = *(const float4*)(gvec + pt * 16 + quad * 4);
          v[0] *= gg.x; v[1] *= gg.y; v[2] *= gg.z; v[3] *= gg.w;
        }
        u32x2 pk = {pack2(v[0], v[1]), pack2(v[2], v[3])};
        *(u32x2*)(rp + pt * 16) = pk;
        if (is_dqkv) {
          if (qt == 0 && l15 == 0) *(u32x2*)(halo + pt * 16) = pk;
          if (qt == QT - 1 && l15 == 15) *(u32x2*)(halo + 768 + pt * 16) = pk;
        }
      }
    }
  }
}

DI void g3_tile(const Params& p, int L, int tile, u16* smem) {
  const int mt = tile >> 2, nt = tile & 3;
  const int m0 = mt * TM, n0 = nt * 128;
  const int tid = otid(), lane = tid & 63, wave = tid >> 6;
  const int wn = wave & 1, wq = wave >> 1, l15 = lane & 15, quad = lane >> 4;
  float* rstd_s = (float*)(smem + 384 * LDS_STRIDE);
  __syncthreads();
  rstd_s[tid] = ((const float*)(p.ws + OFF_MEMRSTD))[m0 + tid];
  f32x4 acc[4][QT];
  QSrc q; int mloc;
  if (m0 < 2048) { q.base = p.mem_prompt; mloc = m0; } else { q.base = p.mem_sample; mloc = m0 - 2048; }
  q.ldq = 1024;
  const u16* W = (const u16*)(p.ws + OFF_WMKV) + ((size_t)L * 512 + n0) * 1024;
  gemm_core<1>(acc, W, q, mloc, smem);
  u16* KM = (u16*)(p.ws + OFF_KM);
  u16* VMT = (u16*)(p.ws + OFF_VMT);
#pragma unroll
  for (int qt = 0; qt < QT; ++qt) {
    int r = m0 + wq * 128 + qt * 16 + l15;
    float rs = rstd_s[wq * 128 + qt * 16 + l15];
    int b = r >> 8, m = r & 255;
#pragma unroll
    for (int pt = 0; pt < 4; ++pt) {
      int n = n0 + wn * 64 + pt * 16 + quad * 4;
      if (n < 256) {
        *(uint2*)(KM + (size_t)r * 256 + n) = make_uint2(pack2(acc[pt][qt][0] * rs, acc[pt][qt][1] * rs), pack2(acc[pt][qt][2] * rs, acc[pt][qt][3] * rs));
      } else {
#pragma unroll
        for (int j = 0; j < 4; ++j) {
          int nn = n + j - 256;
          VMT[((size_t)b * 256 + nn) * 256 + m] = f2bf(acc[pt][qt][j] * rs);
        }
      }
    }
  }
}

DI void g2_tile(const Params& p, int L, int tile, u16* smem) {
  int mt, nt;
  {
    const int xcd = tile & 7, lb = (tile & 511) >> 3, rnd = tile >> 9;
    const int j = lb + 64 * rnd;
    const int rr = j & 63;
    mt = xcd * 32 + (j >> 6) * 8 + (rr & 7); nt = rr >> 3;
  }
  const int m0 = mt * TM, n0 = nt * 128;
  const int tid = otid(), lane = tid & 63, wave = tid >> 6;
  const int wn = wave & 1, wq = wave >> 1, l15 = lane & 15, quad = lane >> 4;
  f32x4 acc[4][QT];
  QSrc q; q.base = nullptr; q.ldq = 0;
  q.c0 = (const u16*)(p.ws + OFF_C0); q.c1 = (const u16*)(p.ws + OFF_C1);
  q.c2 = (const u16*)(p.ws + OFF_C2); q.c3 = (const u16*)(p.ws + OFF_C3);
  const u16* W = (const u16*)(p.ws + OFF_WOUT) + ((size_t)L * 1024 + n0) * 1024;
  gemm_core<2>(acc, W, q, m0, smem);
  u16* HI = (u16*)p.out; u16* LO = HI + (size_t)T_TOK * 1024;
  float* SUMSQ = (float*)(p.ws + OFF_SUMSQ);
  float* HF = (float*)(p.ws + OFF_HFINAL);
#pragma unroll
  for (int qt = 0; qt < QT; ++qt) {
    int token = m0 + wq * 128 + qt * 16 + l15;
    float ss = 0.f;
#pragma unroll
    for (int pt = 0; pt < 4; ++pt) {
      int n = n0 + wn * 64 + pt * 16 + quad * 4;
      size_t idx = (size_t)token * 1024 + n;
      uint2 h = *(const uint2*)(HI + idx);
      float v[4];
      v[0] = bf2f(h.x & 0xffff) + acc[pt][qt][0];
      v[1] = bf2f(h.x >> 16) + acc[pt][qt][1];
      v[2] = bf2f(h.y & 0xffff) + acc[pt][qt][2];
      v[3] = bf2f(h.y >> 16) + acc[pt][qt][3];
#pragma unroll
      for (int j = 0; j < 4; ++j) ss += v[j] * v[j];
      if (L == 3) {
        *(float4*)(HF + idx) = make_float4(v[0], v[1], v[2], v[3]);
      } else {
        *(uint2*)(HI + idx) = make_uint2(pack2(v[0], v[1]), pack2(v[2], v[3]));
      }
    }
    ss += __shfl_xor(ss, 16); ss += __shfl_xor(ss, 32);
    if (quad == 0) SUMSQ[(size_t)token * 16 + nt * 2 + wn] = ss;
  }
}

DI void attn_block(u16* Qp, const u16* Kp, int kstride, const u16* VTp, int Lk, const u16* Gp, u16* smem) {
  const int tid = otid(), lane = tid & 63, wave = tid >> 6;
  const int l15 = lane & 15, quad = lane >> 4;
  u16* Ks = smem; u16* Vs = smem + 64 * LDS_STRIDE;
  bf16x8 qf[2][2];
#pragma unroll
  for (int qt = 0; qt < 2; ++qt)
#pragma unroll
    for (int ks = 0; ks < 2; ++ks)
      qf[qt][ks] = *(const bf16x8*)(Qp + (size_t)(wave * 32 + qt * 16 + l15) * 256 + ks * 32 + quad * 8);
  f32x4 o[4][2];
#pragma unroll
  for (int a = 0; a < 4; ++a)
#pragma unroll
    for (int b = 0; b < 2; ++b) o[a][b] = (f32x4){0.f, 0.f, 0.f, 0.f};
  float mrun[2] = {-1e30f, -1e30f}, lsum[2] = {0.f, 0.f};
  u32x4 kr[2], vr[2];
  const int nkt = Lk >> 6;
#pragma unroll
  for (int i = 0; i < 2; ++i) {
    int c = tid + 256 * i; int row = c >> 3, kc = c & 7;
    kr[i] = *(const u32x4*)(Kp + (size_t)row * kstride + kc * 8);
    vr[i] = *(const u32x4*)(VTp + (size_t)row * Lk + kc * 8);
  }
#pragma unroll 1
  for (int kt = 0; kt < nkt; ++kt) {
    __syncthreads();
#pragma unroll
    for (int i = 0; i < 2; ++i) {
      int c = tid + 256 * i; int row = c >> 3, kc = c & 7;
      *(u32x4*)(Ks + row * LDS_STRIDE + kc * 8) = kr[i];
      *(u32x4*)(Vs + row * LDS_STRIDE + kc * 8) = vr[i];
    }
    __syncthreads();
    if (kt + 1 < nkt) {
      int key0 = (kt + 1) * 64;
#pragma unroll
      for (int i = 0; i < 2; ++i) {
        int c = tid + 256 * i; int row = c >> 3, kc = c & 7;
        kr[i] = *(const u32x4*)(Kp + (size_t)(key0 + row) * kstride + kc * 8);
        vr[i] = *(const u32x4*)(VTp + (size_t)row * Lk + key0 + kc * 8);
      }
    }
    f32x4 s[4][2];
#pragma unroll
    for (int a = 0; a < 4; ++a)
#pragma unroll
      for (int b = 0; b < 2; ++b) s[a][b] = (f32x4){0.f, 0.f, 0.f, 0.f};
#pragma unroll
    for (int ks = 0; ks < 2; ++ks)
#pragma unroll
      for (int k4 = 0; k4 < 4; ++k4) {
        bf16x8 kf = *(const bf16x8*)(Ks + (k4 * 16 + l15) * LDS_STRIDE + ks * 32 + quad * 8);
#pragma unroll
        for (int qt = 0; qt < 2; ++qt) s[k4][qt] = mfma16(kf, qf[qt][ks], s[k4][qt]);
      }
    bf16x8 pq[2][2];
#pragma unroll
    for (int qt = 0; qt < 2; ++qt) {
      float mx = -1e30f;
#pragma unroll
      for (int k4 = 0; k4 < 4; ++k4)
#pragma unroll
        for (int j = 0; j < 4; ++j) mx = fmaxf(mx, s[k4][qt][j]);
      mx = fmaxf(mx, __shfl_xor(mx, 16)); mx = fmaxf(mx, __shfl_xor(mx, 32));
      float mn = fmaxf(mrun[qt], mx);
      float alpha = fast_exp2(mrun[qt] - mn);
      mrun[qt] = mn;
      float ps = 0.f;
#pragma unroll
      for (int k4 = 0; k4 < 4; ++k4)
#pragma unroll
        for (int j = 0; j < 4; ++j) { float e = fast_exp2(s[k4][qt][j] - mn); s[k4][qt][j] = e; ps += e; }
      lsum[qt] = lsum[qt] * alpha + ps;
#pragma unroll
      for (int dt = 0; dt < 4; ++dt)
#pragma unroll
        for (int j = 0; j < 4; ++j) o[dt][qt][j] *= alpha;
#pragma unroll
      for (int k2 = 0; k2 < 2; ++k2) {
        u32x4 u = (u32x4){pack2(s[2 * k2][qt][0], s[2 * k2][qt][1]), pack2(s[2 * k2][qt][2], s[2 * k2][qt][3]),
                          pack2(s[2 * k2 + 1][qt][0], s[2 * k2 + 1][qt][1]), pack2(s[2 * k2 + 1][qt][2], s[2 * k2 + 1][qt][3])};
        pq[qt][k2] = __builtin_bit_cast(bf16x8, u);
      }
    }
#pragma unroll
    for (int dt = 0; dt < 4; ++dt)
#pragma unroll
      for (int k2 = 0; k2 < 2; ++k2) {
        const u16* vrow = Vs + (dt * 16 + l15) * LDS_STRIDE + quad * 4;
        u32x2 a = *(const u32x2*)(vrow + (2 * k2) * 16), b = *(const u32x2*)(vrow + (2 * k2 + 1) * 16);
        bf16x8 vf = __builtin_bit_cast(bf16x8, (u32x4){a.x, a.y, b.x, b.y});
#pragma unroll
        for (int qt = 0; qt < 2; ++qt) o[dt][qt] = mfma16(vf, pq[qt][k2], o[dt][qt]);
      }
  }
#pragma unroll
  for (int qt = 0; qt < 2; ++qt) {
    float l = lsum[qt];
    l += __shfl_xor(l, 16); l += __shfl_xor(l, 32);
    float inv = 1.f / l;
    size_t rowoff = (size_t)(wave * 32 + qt * 16 + l15) * 256;
#pragma unroll
    for (int dt = 0; dt < 4; ++dt) {
      uint2 g = *(const uint2*)(Gp + rowoff + dt * 16 + quad * 4);
      float v0 = o[dt][qt][0] * inv * bf2f(g.x & 0xffff), v1 = o[dt][qt][1] * inv * bf2f(g.x >> 16);
      float v2 = o[dt][qt][2] * inv * bf2f(g.y & 0xffff), v3 = o[dt][qt][3] * inv * bf2f(g.y >> 16);
      *(uint2*)(Qp + rowoff + dt * 16 + quad * 4) = make_uint2(pack2(v0, v1), pack2(v2, v3));
    }
  }
}

DI float softplusf(float x) { return fmaxf(x, 0.f) + flog(1.f + fexp(-fabsf(x))); }
DI float logsigmoidf(float x) { return fminf(x, 0.f) - flog(1.f + fexp(-fabsf(x))); }

DI void scan_block_naive(const Params& p, int L, int seq, int h, u16* smem) {
  const int tid = otid(), lane = tid & 63, wave = tid >> 6;
  const int dir = wave & 1, kind = wave >> 1;
  const int sbase = seq_base(seq), S = seq_len(seq);
  float* bc = (float*)smem + wave * 160;
  const u16* DQKV = (const u16*)(p.ws + OFF_DQKV) + (size_t)sbase * 768 + h * 64 + lane;
  const float* SMALL = (const float*)(p.ws + OFF_SMALL) + (size_t)sbase * 48;
  float St[64];
#pragma unroll
  for (int d = 0; d < 64; ++d) St[d] = 0.f;
  float cw[3][3];
#pragma unroll
  for (int i = 0; i < 3; ++i)
#pragma unroll
    for (int s = 0; s < 3; ++s) cw[i][s] = p.gdn_conv_w[((size_t)L * 3 + i) * 768 + s * 256 + h * 64 + lane];
  const float A = fexp(p.gdn_a_log[L * 8 + dir * 4 + h]);
  const float dtb = p.gdn_dt_bias[L * 8 + dir * 4 + h];
  const float onorm = (kind == 0 ? p.gdn_out_norm_g : p.gla_out_norm_g)[L * 64 + lane];
  float wup[16]; float bg = 0.f;
  {
    int d = lane & 31;
#pragma unroll
    for (int r = 0; r < 16; ++r) wup[r] = p.gla_w_gate_up[(((size_t)L * 2 + dir) * 16 + r) * 128 + h * 32 + d];
    bg = p.gla_b_gate[((size_t)L * 2 + dir) * 128 + h * 32 + d];
  }
  u16* OUT = (u16*)(p.ws + (kind == 0 ? OFF_C1 : OFF_C2)) + (size_t)sbase * 256 + h * 64 + lane;
  const u16* GATE = (const u16*)(p.ws + (kind == 0 ? OFF_DGATE : OFF_LGATE)) + (size_t)sbase * 256 + h * 64 + lane;
  const u16* LQ = (const u16*)(p.ws + OFF_LQ) + (size_t)sbase * 128 + h * 32;
  const u16* LK = (const u16*)(p.ws + OFF_LK) + (size_t)sbase * 128 + h * 32;
  const u16* LV = (const u16*)(p.ws + OFF_LV) + (size_t)sbase * 256 + h * 64 + lane;
  const int step = dir ? -1 : 1;
  int t = dir ? S - 1 : 0;
  float rb[3], r0[3], r1[3], r2[3];
#pragma unroll
  for (int s = 0; s < 3; ++s) {
    rb[s] = 0.f;
    r0[s] = bf2f(DQKV[(size_t)t * 768 + s * 256]);
    r1[s] = bf2f(DQKV[(size_t)(t + step) * 768 + s * 256]);
    r2[s] = bf2f(DQKV[(size_t)(t + 2 * step) * 768 + s * 256]);
  }
#pragma unroll 1
  for (int n = 0; n < S; ++n, t += step) {
    float o;
    if (kind == 0) {
      float cv[3];
#pragma unroll
      for (int s = 0; s < 3; ++s) {
        float xm = dir ? r1[s] : rb[s], xp = dir ? rb[s] : r1[s];
        cv[s] = siluf(xm * cw[0][s] + r0[s] * cw[1][s] + xp * cw[2][s]);
      }
      float ssq = wave_sum(cv[0] * cv[0]), ssk = wave_sum(cv[1] * cv[1]);
      float qn = cv[0] * rsqrtf(ssq + EPSF), kn = cv[1] * rsqrtf(ssk + EPSF);
      bc[lane] = qn; bc[64 + lane] = kn;
      float beta = 1.f / (1.f + fexp(-SMALL[(size_t)t * 48 + dir * 4 + h]));
      float g = -A * softplusf(SMALL[(size_t)t * 48 + 8 + dir * 4 + h] + dtb);
      float eg = fexp(g);
#pragma unroll
      for (int s = 0; s < 3; ++s) { rb[s] = r0[s]; r0[s] = r1[s]; r1[s] = r2[s]; }
      int tn = t + 3 * step;
      bool ok = tn >= 0 && tn < S;
#pragma unroll
      for (int s = 0; s < 3; ++s) r2[s] = ok ? bf2f(DQKV[(size_t)tn * 768 + s * 256]) : 0.f;
      __builtin_amdgcn_wave_barrier();
      float kS = 0.f;
#pragma unroll
      for (int d4 = 0; d4 < 16; ++d4) {
        float4 kk = *(const float4*)(bc + 64 + d4 * 4);
        kS += kk.x * St[d4 * 4] + kk.y * St[d4 * 4 + 1] + kk.z * St[d4 * 4 + 2] + kk.w * St[d4 * 4 + 3];
      }
      float w = beta * (cv[2] - eg * kS);
      o = 0.f;
#pragma unroll
      for (int d4 = 0; d4 < 16; ++d4) {
        float4 kk = *(const float4*)(bc + 64 + d4 * 4);
        float4 qq = *(const float4*)(bc + d4 * 4);
        St[d4 * 4] = eg * St[d4 * 4] + kk.x * w; o += qq.x * St[d4 * 4];
        St[d4 * 4 + 1] = eg * St[d4 * 4 + 1] + kk.y * w; o += qq.y * St[d4 * 4 + 1];
        St[d4 * 4 + 2] = eg * St[d4 * 4 + 2] + kk.z * w; o += qq.z * St[d4 * 4 + 2];
        St[d4 * 4 + 3] = eg * St[d4 * 4 + 3] + kk.w * w; o += qq.w * St[d4 * 4 + 3];
      }
      o *= 0.125f;
      __builtin_amdgcn_wave_barrier();
    } else {
      float lg = bg;
      const float* low = SMALL + (size_t)t * 48 + 16 + dir * 16;
#pragma unroll
      for (int r = 0; r < 16; ++r) lg += low[r] * wup[r];
      float egk = fexp(logsigmoidf(lg) * (1.f / 16.f));
      float qk = lane < 32 ? bf2f(LQ[(size_t)t * 128 + lane]) : bf2f(LK[(size_t)t * 128 + lane - 32]);
      float v = bf2f(LV[(size_t)t * 256]);
      bc[lane] = qk;
      if (lane < 32) bc[64 + lane] = egk;
      __builtin_amdgcn_wave_barrier();
      o = 0.f;
#pragma unroll
      for (int d4 = 0; d4 < 8; ++d4) {
        float4 qq = *(const float4*)(bc + d4 * 4);
        float4 kk = *(const float4*)(bc + 32 + d4 * 4);
        float4 ee = *(const float4*)(bc + 64 + d4 * 4);
        St[d4 * 4] = ee.x * St[d4 * 4] + kk.x * v; o += qq.x * St[d4 * 4];
        St[d4 * 4 + 1] = ee.y * St[d4 * 4 + 1] + kk.y * v; o += qq.y * St[d4 * 4 + 1];
        St[d4 * 4 + 2] = ee.z * St[d4 * 4 + 2] + kk.z * v; o += qq.z * St[d4 * 4 + 2];
        St[d4 * 4 + 3] = ee.w * St[d4 * 4 + 3] + kk.w * v; o += qq.w * St[d4 * 4 + 3];
      }
      o *= 0.17677669529663687f;
      __builtin_amdgcn_wave_barrier();
    }
    if (n < (S >> 1)) {
      OUT[(size_t)t * 256] = f2bf(o);
    } else {
      float tot = o + bf2f(OUT[(size_t)t * 256]);
      float ss = wave_sum(tot * tot);
      float y = tot * rsqrtf(ss * (1.f / 64.f) + EPSF) * onorm * bf2f(GATE[(size_t)t * 256]);
      OUT[(size_t)t * 256] = f2bf(y);
    }
    __syncthreads();
  }
}

DI void conv_load32(float (&x)[32], const u16* src) {
#pragma unroll
  for (int i = 0; i < 4; ++i) {
    u32x4 r = *(const u32x4*)(src + i * 8);
#pragma unroll
    for (int j = 0; j < 4; ++j) { x[i * 8 + 2 * j] = bf2f(r[j] & 0xffff); x[i * 8 + 2 * j + 1] = bf2f(r[j] >> 16); }
  }
}
DI void prep_task(const Params& p, int L, int task, u16* smem) {
  const int mt = task >> 2, h = task & 3;
  const int m0 = mt * 128;
  const int tid = otid(), tok = tid >> 1, half = tid & 1;
  const int seq = seq_of_token(m0), sbase = seq_base(seq), S = seq_len(seq);
  const int token = m0 + tok, tpos = token - sbase;
  u16* DQ = (u16*)(p.ws + OFF_DQKV);
  const u16* HALO = (const u16*)(p.ws + OFF_HALO);
  u16* LV = (u16*)(p.ws + OFF_LV);
  u32x4 raw[3][3][4];
  const float scp = tpos > 0 ? 1.f : 0.f, scn = tpos < S - 1 ? 1.f : 0.f;
#pragma unroll
  for (int s = 0; s < 3; ++s) {
    const int col0 = s * 256 + h * 64 + half * 32;
    const u16* pc = DQ + (size_t)token * 768 + col0;
    const u16* pp = tpos > 0 ? (tok > 0 ? pc - 768 : HALO + ((size_t)(mt - 1) * 2 + 1) * 768 + col0) : pc;
    const u16* pn = tpos < S - 1 ? (tok < 127 ? pc + 768 : HALO + ((size_t)(mt + 1) * 2 + 0) * 768 + col0) : pc;
#pragma unroll
    for (int i = 0; i < 4; ++i) { raw[s][0][i] = *(const u32x4*)(pp + i * 8); raw[s][1][i] = *(const u32x4*)(pc + i * 8); raw[s][2][i] = *(const u32x4*)(pn + i * 8); }
  }
  u32x4 res[3][4];
#pragma unroll
  for (int s = 0; s < 3; ++s) {
    const int col0 = s * 256 + h * 64 + half * 32;
    const float* w0 = p.gdn_conv_w + ((size_t)L * 3 + 0) * 768 + col0;
    const float* w1 = w0 + 768; const float* w2 = w0 + 2 * 768;
    float acc[32];
#pragma unroll
    for (int i = 0; i < 4; ++i)
#pragma unroll
      for (int j = 0; j < 4; ++j) {
        const int c = i * 8 + 2 * j;
        const uint32_t rp = raw[s][0][i][j], rc = raw[s][1][i][j], rn = raw[s][2][i][j];
        acc[c] = bf2f(rc & 0xffff) * w1[c] + scp * (bf2f(rp & 0xffff) * w0[c]) + scn * (bf2f(rn & 0xffff) * w2[c]);
        acc[c + 1] = bf2f(rc >> 16) * w1[c + 1] + scp * (bf2f(rp >> 16) * w0[c + 1]) + scn * (bf2f(rn >> 16) * w2[c + 1]);
      }
    float ss = 0.f;
#pragma unroll
    for (int c = 0; c < 32; ++c) { acc[c] = siluf(acc[c]); ss += acc[c] * acc[c]; }
    float sc = 1.f;
    if (s < 2) { ss += __shfl_xor(ss, 1); sc = rsqrtf(ss + EPSF); }
#pragma unroll
    for (int i = 0; i < 4; ++i)
      res[s][i] = (u32x4){pack2(acc[i * 8] * sc, acc[i * 8 + 1] * sc), pack2(acc[i * 8 + 2] * sc, acc[i * 8 + 3] * sc),
                          pack2(acc[i * 8 + 4] * sc, acc[i * 8 + 5] * sc), pack2(acc[i * 8 + 6] * sc, acc[i * 8 + 7] * sc)};
  }
  __syncthreads();
#pragma unroll
  for (int s = 0; s < 3; ++s)
#pragma unroll
    for (int i = 0; i < 4; ++i) *(u32x4*)(DQ + (size_t)token * 768 + s * 256 + h * 64 + half * 32 + i * 8) = res[s][i];
}

DI bf16x8 pk8(f32x4 a, f32x4 b) { u32x4 u = {pack2(a[0], a[1]), pack2(a[2], a[3]), pack2(b[0], b[1]), pack2(b[2], b[3])}; return __builtin_bit_cast(bf16x8, u); }
DI bf16x8 pk4(f32x4 a) { u32x4 u = {pack2(a[0], a[1]), pack2(a[2], a[3]), 0u, 0u}; return __builtin_bit_cast(bf16x8, u); }
DI bf16x8 pk8n(f32x4 a, f32x4 b) { u32x4 u = {pack2(-a[0], -a[1]), pack2(-a[2], -a[3]), pack2(-b[0], -b[1]), pack2(-b[2], -b[3])}; return __builtin_bit_cast(bf16x8, u); }
DI u32x2 rev4(u32x2 v) { u32x2 r = {(v.y >> 16) | (v.y << 16), (v.x >> 16) | (v.x << 16)}; return r; }
DI f32x4 unpack4(u32x2 v) { f32x4 r = {bf2f(v.x & 0xffff), bf2f(v.x >> 16), bf2f(v.y & 0xffff), bf2f(v.y >> 16)}; return r; }
#define F4Z ((f32x4){0.f, 0.f, 0.f, 0.f})

DI void scan_combine(u16* OUT, const u16* SLOT, int slot_stride, const u16* GATE, int S, int tid) {
  const int q4 = (tid & 3) * 16;
#pragma unroll 1
  for (int t0 = 0; t0 < S; t0 += 128) {
    u32x4 a[2][2], b[2][2], g[2][2];
#pragma unroll
    for (int k = 0; k < 2; ++k) {
      size_t tok = (size_t)(t0 + k * 64 + (tid >> 2));
#pragma unroll
      for (int i = 0; i < 2; ++i) {
        a[k][i] = *(const u32x4*)(OUT + tok * 256 + q4 + i * 8);
        b[k][i] = *(const u32x4*)(SLOT + tok * slot_stride + q4 + i * 8);
        g[k][i] = *(const u32x4*)(GATE + tok * 256 + q4 + i * 8);
      }
    }
#pragma unroll
    for (int k = 0; k < 2; ++k) {
      size_t tok = (size_t)(t0 + k * 64 + (tid >> 2));
      float v[16]; float ss = 0.f;
#pragma unroll
      for (int i = 0; i < 2; ++i)
#pragma unroll
        for (int w = 0; w < 4; ++w) {
          float x0 = bf2f(a[k][i][w] & 0xffff) + bf2f(b[k][i][w] & 0xffff), x1 = bf2f(a[k][i][w] >> 16) + bf2f(b[k][i][w] >> 16);
          v[i * 8 + w * 2] = x0; v[i * 8 + w * 2 + 1] = x1; ss += x0 * x0 + x1 * x1;
        }
      ss += __shfl_xor(ss, 1); ss += __shfl_xor(ss, 2);
      const float r = rsqrtf(ss * (1.f / 64.f) + EPSF);
#pragma unroll
      for (int i = 0; i < 2; ++i) {
        u32x4 o;
#pragma unroll
        for (int w = 0; w < 4; ++w)
          o[w] = pack2(v[i * 8 + w * 2] * r * bf2f(g[k][i][w] & 0xffff), v[i * 8 + w * 2 + 1] * r * bf2f(g[k][i][w] >> 16));
        *(u32x4*)(OUT + tok * 256 + q4 + i * 8) = o;
      }
    }
  }
}

#define SCAN_R 2
#define SCAN_SLOT_V4 10
DI void ring_wait(volatile int* f, int v) { while (*f < v) __builtin_amdgcn_s_sleep(1); }

DI void dn_task(const Params& p, int L, int seq, int h, u16* smem) {
  const int tid = otid(), lane = tid & 63, wave = tid >> 6, l15 = lane & 15, quad = lane >> 4;
  const int dir = wave >> 1, role = wave & 1;
  const int sbase = seq_base(seq), S = seq_len(seq), N = S >> 4;
  u32x4* slots = (u32x4*)smem + (size_t)dir * SCAN_R * SCAN_SLOT_V4 * 64 + lane;
  volatile int* ready = (volatile int*)(smem + 20480) + dir * 8;
  volatile int* done = ready + 4;
  __syncthreads();
  if (tid < 16) ((volatile int*)(smem + 20480))[tid] = 0;
  __syncthreads();
  u16* OUT = (u16*)(p.ws + OFF_C1) + (size_t)sbase * 256 + h * 64;
  u16* SLOT = (u16*)(p.ws + OFF_DQKV) + (size_t)sbase * 768 + h * 64;
  if (role == 0) {
    const u16* QK = (const u16*)(p.ws + OFF_DQKV) + (size_t)sbase * 768 + h * 64;
    const float* SM = (const float*)(p.ws + OFF_SMALL) + (size_t)sbase * 48 + dir * 4 + h;
    const float A = fexp(p.gdn_a_log[L * 8 + dir * 4 + h]);
    const float dtb = p.gdn_dt_bias[L * 8 + dir * 4 + h];
    bf16x8 selE, selO;
    {
      uint32_t w = ((l15 >> 2) == quad) ? (0x3F80u << ((l15 & 1) * 16)) : 0u;
      uint32_t w0 = (l15 & 2) ? 0u : w, w1 = (l15 & 2) ? w : 0u;
      selE = __builtin_bit_cast(bf16x8, (u32x4){w0, w1, 0u, 0u});
      selO = __builtin_bit_cast(bf16x8, (u32x4){0u, 0u, w0, w1});
    }
    const int ca0 = dir ? 12 - quad * 4 : quad * 4;
    u32x2 qraw[4], kraw[4], vraw[4]; float braw, graw;
    auto load_step = [&](int n) {
      int t0 = dir ? S - 16 * (n + 1) : 16 * n;
      int rl = dir ? t0 + 15 - l15 : t0 + l15;
      const u16* qrow = QK + (size_t)rl * 768;
#pragma unroll
      for (int s = 0; s < 2; ++s) {
        qraw[2 * s] = *(const u32x2*)(qrow + 32 * s + quad * 4);
        qraw[2 * s + 1] = *(const u32x2*)(qrow + 32 * s + 16 + quad * 4);
        kraw[2 * s] = *(const u32x2*)(qrow + 256 + 32 * s + quad * 4);
        kraw[2 * s + 1] = *(const u32x2*)(qrow + 256 + 32 * s + 16 + quad * 4);
      }
#pragma unroll
      for (int s = 0; s < 2; ++s) {
        vraw[2 * s] = *(const u32x2*)(qrow + 512 + 32 * s + quad * 4);
        vraw[2 * s + 1] = *(const u32x2*)(qrow + 512 + 32 * s + 16 + quad * 4);
      }
      braw = SM[(size_t)rl * 48]; graw = SM[(size_t)rl * 48 + 8];
    };
#pragma unroll 1
    for (int half = 0; half < 2; ++half) {
      const int nbeg = half * (N >> 1), nend = nbeg + (N >> 1);
      load_step(nbeg);
      asm volatile("" ::: "memory");
#pragma unroll 1
      for (int n = nbeg; n < nend; ++n) {
        bf16x8 qn[2], kn[2];
#pragma unroll
        for (int s = 0; s < 2; ++s) {
          qn[s] = __builtin_bit_cast(bf16x8, (u32x4){qraw[2 * s].x, qraw[2 * s].y, qraw[2 * s + 1].x, qraw[2 * s + 1].y});
          kn[s] = __builtin_bit_cast(bf16x8, (u32x4){kraw[2 * s].x, kraw[2 * s].y, kraw[2 * s + 1].x, kraw[2 * s + 1].y});
        }
        bf16x8 vn[2];
#pragma unroll
        for (int s = 0; s < 2; ++s) vn[s] = __builtin_bit_cast(bf16x8, (u32x4){vraw[2 * s].x, vraw[2 * s].y, vraw[2 * s + 1].x, vraw[2 * s + 1].y});
        float cb = braw, cg = graw;
        load_step(n + 1 < nend ? n + 1 : n);
        asm volatile("" : "+v"(qn[0]), "+v"(qn[1]), "+v"(kn[0]), "+v"(kn[1]), "+v"(cb), "+v"(cg), "+v"(vn[0]), "+v"(vn[1]) :: "memory");
        f32x4 VC[4];
#pragma unroll
        for (int et = 0; et < 4; ++et) VC[et] = mfma16(vn[et >> 1], (et & 1) ? selO : selE, F4Z);
        const float beta_l = 1.f / (1.f + fexp(-cb));
        float b_l = -A * softplusf(cg + dtb);
#pragma unroll
        for (int o = 1; o < 16; o <<= 1) { float t = __shfl_up(b_l, o, 16); if (l15 >= o) b_l += t; }
        float bq[4], betaq[4];
#pragma unroll
        for (int j = 0; j < 4; ++j) { bq[j] = __shfl(b_l, quad * 4 + j); betaq[j] = __shfl(beta_l, quad * 4 + j); }
        const float blast = __shfl(b_l, 15);
        const float cd = fexp(blast);
        bf16x8 rup[4], rwp[4], kdp[4];
#pragma unroll
        for (int t = 0; t < 4; ++t) {
          f32x4 KC = mfma16(kn[t >> 1], (t & 1) ? selO : selE, F4Z);
          f32x4 ru, rw, kd;
#pragma unroll
          for (int j = 0; j < 4; ++j) {
            ru[j] = betaq[j] * VC[t][j];
            rw[j] = betaq[j] * fexp(bq[j]) * KC[j];
            kd[j] = KC[j] * fexp(blast - bq[j]);
          }
          rup[t] = pk4(ru); rwp[t] = pk4(rw); kdp[t] = pk4(kd);
        }
        f32x4 kk = mfma16(kn[0], kn[0], F4Z); kk = mfma16(kn[1], kn[1], kk);
        f32x4 kq = mfma16(kn[0], qn[0], F4Z); kq = mfma16(kn[1], qn[1], kq);
        f32x4 P1, Q1, Z, AT;
#pragma unroll
        for (int j = 0; j < 4; ++j) {
          int r = quad * 4 + j;
          float ef = fexp(fminf(b_l - bq[j], 0.f));
          P1[j] = (r > l15) ? betaq[j] * kk[j] * fexp(fminf(bq[j] - b_l, 0.f)) : 0.f;
          Q1[j] = (l15 > r) ? beta_l * kk[j] * ef : 0.f;
          Z[j] = (r == l15 ? 1.f : 0.f) - Q1[j];
          AT[j] = (l15 >= r) ? kq[j] * 0.125f * ef : 0.f;
        }
        const bf16x8 atp = pk4(AT);
        {
          bf16x8 p1 = pk4(P1), q1 = pk4(Q1);
          f32x4 P2 = mfma16(q1, p1, F4Z), Q2 = mfma16(p1, q1, F4Z);
          bf16x8 p2 = pk4(P2), q2 = pk4(Q2);
          Z = mfma16(p2, pk4(Z), Z);
          f32x4 P4 = mfma16(q2, p2, F4Z), Q4 = mfma16(p2, q2, F4Z);
          bf16x8 p4 = pk4(P4), q4 = pk4(Q4);
          Z = mfma16(p4, pk4(Z), Z);
          f32x4 P8 = mfma16(q4, p4, F4Z);
          Z = mfma16(pk4(P8), pk4(Z), Z);
        }
        const bf16x8 zp = pk4(Z);
        bf16x8 wn0, wn1;
        {
          f32x4 w0 = mfma16(rwp[0], zp, F4Z), w1 = mfma16(rwp[1], zp, F4Z);
          wn0 = pk8n(w0, w1);
          f32x4 w2 = mfma16(rwp[2], zp, F4Z), w3 = mfma16(rwp[3], zp, F4Z);
          wn1 = pk8n(w2, w3);
        }
        const float eq_l = 0.125f * fexp(b_l);
        const int slot = n & (SCAN_R - 1);
        ring_wait(done + slot, n - SCAN_R + 1);
        asm volatile("" ::: "memory");
        u32x4* sp = slots + slot * SCAN_SLOT_V4 * 64;
        const u32x4 zz = __builtin_bit_cast(u32x4, zp), aa = __builtin_bit_cast(u32x4, atp);
        const u32x4 r0 = __builtin_bit_cast(u32x4, rup[0]), r1 = __builtin_bit_cast(u32x4, rup[1]), r2 = __builtin_bit_cast(u32x4, rup[2]), r3 = __builtin_bit_cast(u32x4, rup[3]);
        const u32x4 k0 = __builtin_bit_cast(u32x4, kdp[0]), k1 = __builtin_bit_cast(u32x4, kdp[1]), k2 = __builtin_bit_cast(u32x4, kdp[2]), k3 = __builtin_bit_cast(u32x4, kdp[3]);
        sp[0 * 64] = (u32x4){zz.x, zz.y, aa.x, aa.y};
        sp[1 * 64] = (u32x4){r0.x, r0.y, r1.x, r1.y};
        sp[2 * 64] = (u32x4){r2.x, r2.y, r3.x, r3.y};
        sp[3 * 64] = __builtin_bit_cast(u32x4, wn0);
        sp[4 * 64] = __builtin_bit_cast(u32x4, wn1);
        sp[5 * 64] = __builtin_bit_cast(u32x4, qn[0]);
        sp[6 * 64] = __builtin_bit_cast(u32x4, qn[1]);
        sp[7 * 64] = (u32x4){k0.x, k0.y, k1.x, k1.y};
        sp[8 * 64] = (u32x4){k2.x, k2.y, k3.x, k3.y};
        sp[9 * 64] = (u32x4){__float_as_uint(eq_l), __float_as_uint(cd), 0u, 0u};
        asm volatile("s_waitcnt lgkmcnt(0)" ::: "memory");
        ready[slot] = n + 1;
        asm volatile("" ::: "memory");
      }
      __syncthreads();
    }
  } else {
    f32x4 St[4][4];
#pragma unroll
    for (int a2 = 0; a2 < 4; ++a2)
#pragma unroll
      for (int b2 = 0; b2 < 4; ++b2) St[a2][b2] = F4Z;
    u32x2 rpk[4] = {(u32x2){0u, 0u}, (u32x2){0u, 0u}, (u32x2){0u, 0u}, (u32x2){0u, 0u}};
    u16* prev_ptr = OUT + (size_t)(dir ? S - 1 - l15 : l15) * 256 + quad * 4;
#pragma unroll 1
    for (int half = 0; half < 2; ++half) {
      const int nbeg = half * (N >> 1), nend = nbeg + (N >> 1);
#pragma unroll 1
      for (int n = nbeg; n < nend; ++n) {
        const int t0 = dir ? S - 16 * (n + 1) : 16 * n;
#pragma unroll
        for (int et = 0; et < 4; ++et) *(u32x2*)(prev_ptr + et * 16) = rpk[et];
        {
          const size_t row = (size_t)(dir ? t0 + 15 - l15 : t0 + l15);
          prev_ptr = half == 0 ? OUT + row * 256 + quad * 4 : SLOT + row * 768 + quad * 4;
        }
        const int slot = n & (SCAN_R - 1);
        ring_wait(ready + slot, n + 1);
        asm volatile("" ::: "memory");
        const u32x4* sp = slots + slot * SCAN_SLOT_V4 * 64;
        const u32x4 m0 = sp[0 * 64], m1 = sp[1 * 64], m2 = sp[2 * 64], m3 = sp[3 * 64], m4 = sp[4 * 64], m5 = sp[5 * 64], m6 = sp[6 * 64], m7 = sp[7 * 64], m8 = sp[8 * 64], m9 = sp[9 * 64];
        asm volatile("s_waitcnt lgkmcnt(0)" ::: "memory");
        done[slot] = n + 1;
        asm volatile("" ::: "memory");
        const bf16x8 zp = __builtin_bit_cast(bf16x8, (u32x4){m0.x, m0.y, 0u, 0u}), atp = __builtin_bit_cast(bf16x8, (u32x4){m0.z, m0.w, 0u, 0u});
        bf16x8 rup[4], kdp[4];
        rup[0] = __builtin_bit_cast(bf16x8, (u32x4){m1.x, m1.y, 0u, 0u}); rup[1] = __builtin_bit_cast(bf16x8, (u32x4){m1.z, m1.w, 0u, 0u});
        rup[2] = __builtin_bit_cast(bf16x8, (u32x4){m2.x, m2.y, 0u, 0u}); rup[3] = __builtin_bit_cast(bf16x8, (u32x4){m2.z, m2.w, 0u, 0u});
        kdp[0] = __builtin_bit_cast(bf16x8, (u32x4){m7.x, m7.y, 0u, 0u}); kdp[1] = __builtin_bit_cast(bf16x8, (u32x4){m7.z, m7.w, 0u, 0u});
        kdp[2] = __builtin_bit_cast(bf16x8, (u32x4){m8.x, m8.y, 0u, 0u}); kdp[3] = __builtin_bit_cast(bf16x8, (u32x4){m8.z, m8.w, 0u, 0u});
        const bf16x8 wn0 = __builtin_bit_cast(bf16x8, m3), wn1 = __builtin_bit_cast(bf16x8, m4);
        const bf16x8 qn0 = __builtin_bit_cast(bf16x8, m5), qn1 = __builtin_bit_cast(bf16x8, m6);
        const float eq_l = __uint_as_float(m9.x), cd = __uint_as_float(m9.y);
        f32x4 O[4];
#pragma unroll
        for (int et = 0; et < 4; ++et) {
          const bf16x8 s01 = pk8(St[0][et], St[1][et]), s23 = pk8(St[2][et], St[3][et]);
          f32x4 vn = mfma16(zp, rup[et], F4Z);
          vn = mfma16(wn0, s01, vn);
          vn = mfma16(wn1, s23, vn);
          f32x4 t1 = mfma16(s01, qn0, F4Z);
          t1 = mfma16(s23, qn1, t1);
#pragma unroll
          for (int j = 0; j < 4; ++j) t1[j] *= eq_l;
          const bf16x8 vnp = pk4(vn);
          O[et] = mfma16(vnp, atp, t1);
#pragma unroll
          for (int dt = 0; dt < 4; ++dt) {
            f32x4 c = St[dt][et];
#pragma unroll
            for (int j = 0; j < 4; ++j) c[j] *= cd;
            St[dt][et] = mfma16(kdp[dt], vnp, c);
          }
        }
#pragma unroll
        for (int et = 0; et < 4; ++et) rpk[et] = (u32x2){pack2(O[et][0], O[et][1]), pack2(O[et][2], O[et][3])};
      }
#pragma unroll
      for (int et = 0; et < 4; ++et) *(u32x2*)(prev_ptr + et * 16) = rpk[et];
      __syncthreads();
    }
  }
  scan_combine(OUT, SLOT, 768, (const u16*)(p.ws + OFF_DGATE) + (size_t)sbase * 256 + h * 64, S, tid);
}

DI void gla_task(const Params& p, int L, int seq, int h, u16* smem) {
  const int tid = otid(), lane = tid & 63, wave = tid >> 6, l15 = lane & 15, quad = lane >> 4;
  const int dir = wave >> 1, role = wave & 1;
  const int sbase = seq_base(seq), S = seq_len(seq), N = S >> 4;
  u32x4* slots = (u32x4*)smem + (size_t)dir * SCAN_R * SCAN_SLOT_V4 * 64 + lane;
  volatile int* ready = (volatile int*)(smem + 20480) + dir * 8;
  volatile int* done = ready + 4;
  __syncthreads();
  if (tid < 16) ((volatile int*)(smem + 20480))[tid] = 0;
  __syncthreads();
  u16* OUT = (u16*)(p.ws + OFF_C2) + (size_t)sbase * 256 + h * 64;
  u16* SLOT = (u16*)(p.ws + OFF_LV) + (size_t)sbase * 256 + h * 64;
  if (role == 0) {
    const u16* LQ = (const u16*)(p.ws + OFF_LQ) + (size_t)sbase * 128 + h * 32;
    const u16* LK = (const u16*)(p.ws + OFF_LK) + (size_t)sbase * 128 + h * 32;
    const u16* LV = (const u16*)(p.ws + OFF_LV) + (size_t)sbase * 256 + h * 64;
    const float* SM = (const float*)(p.ws + OFF_SMALL) + (size_t)sbase * 48 + 16 + dir * 16;
    bf16x8 selE, selO, triB, wupB[2];
    float bias[2];
    {
      uint32_t w = ((l15 >> 2) == quad) ? (0x3F80u << ((l15 & 1) * 16)) : 0u;
      uint32_t w0 = (l15 & 2) ? 0u : w, w1 = (l15 & 2) ? w : 0u;
      selE = __builtin_bit_cast(bf16x8, (u32x4){w0, w1, 0u, 0u});
      selO = __builtin_bit_cast(bf16x8, (u32x4){0u, 0u, w0, w1});
      uint32_t t[2];
#pragma unroll
      for (int k = 0; k < 2; ++k) {
        uint32_t lo = (quad * 4 + 2 * k <= l15) ? 0x3F80u : 0u, hi = (quad * 4 + 2 * k + 1 <= l15) ? 0x3F80u : 0u;
        t[k] = lo | (hi << 16);
      }
      triB = __builtin_bit_cast(bf16x8, (u32x4){t[0], t[1], 0u, 0u});
#pragma unroll
      for (int tt = 0; tt < 2; ++tt) {
        const float* wsrc = p.gla_w_gate_up + (((size_t)L * 2 + dir) * 16 + quad * 4) * 128 + h * 32 + tt * 16 + l15;
        wupB[tt] = __builtin_bit_cast(bf16x8, (u32x4){pack2(wsrc[0], wsrc[128]), pack2(wsrc[256], wsrc[384]), 0u, 0u});
        bias[tt] = p.gla_b_gate[((size_t)L * 2 + dir) * 128 + h * 32 + tt * 16 + l15];
      }
    }
    const int ca0 = dir ? 12 - quad * 4 : quad * 4;
    u32x2 qraw[2], kraw[2], vraw[4]; float4 lowraw;
    auto load_step = [&](int n) {
      int t0 = dir ? S - 16 * (n + 1) : 16 * n;
      int rl = dir ? t0 + 15 - l15 : t0 + l15;
      qraw[0] = *(const u32x2*)(LQ + (size_t)rl * 128 + quad * 4);
      qraw[1] = *(const u32x2*)(LQ + (size_t)rl * 128 + 16 + quad * 4);
      kraw[0] = *(const u32x2*)(LK + (size_t)rl * 128 + quad * 4);
      kraw[1] = *(const u32x2*)(LK + (size_t)rl * 128 + 16 + quad * 4);
#pragma unroll
      for (int s = 0; s < 2; ++s) {
        vraw[2 * s] = *(const u32x2*)(LV + (size_t)rl * 256 + 32 * s + quad * 4);
        vraw[2 * s + 1] = *(const u32x2*)(LV + (size_t)rl * 256 + 32 * s + 16 + quad * 4);
      }
      lowraw = *(const float4*)(SM + (size_t)rl * 48 + quad * 4);
    };
#pragma unroll 1
    for (int half = 0; half < 2; ++half) {
      const int nbeg = half * (N >> 1), nend = nbeg + (N >> 1);
      load_step(nbeg);
      asm volatile("" ::: "memory");
#pragma unroll 1
      for (int n = nbeg; n < nend; ++n) {
        bf16x8 qn = __builtin_bit_cast(bf16x8, (u32x4){qraw[0].x, qraw[0].y, qraw[1].x, qraw[1].y});
        bf16x8 kn = __builtin_bit_cast(bf16x8, (u32x4){kraw[0].x, kraw[0].y, kraw[1].x, kraw[1].y});
        bf16x8 vn[2];
#pragma unroll
        for (int s = 0; s < 2; ++s) vn[s] = __builtin_bit_cast(bf16x8, (u32x4){vraw[2 * s].x, vraw[2 * s].y, vraw[2 * s + 1].x, vraw[2 * s + 1].y});
        bf16x8 lowA = __builtin_bit_cast(bf16x8, (u32x4){pack2(lowraw.x, lowraw.y), pack2(lowraw.z, lowraw.w), 0u, 0u});
        load_step(n + 1 < nend ? n + 1 : n);
        asm volatile("" : "+v"(qn), "+v"(kn), "+v"(lowA), "+v"(vn[0]), "+v"(vn[1]) :: "memory");
        f32x4 VC[4];
#pragma unroll
        for (int et = 0; et < 4; ++et) VC[et] = mfma16(vn[et >> 1], (et & 1) ? selO : selE, F4Z);
        f32x4 bC[2], bN[2];
#pragma unroll
        for (int t = 0; t < 2; ++t) {
          f32x4 g = mfma16(lowA, wupB[t], F4Z);
          f32x4 ghi, glo;
#pragma unroll
          for (int j = 0; j < 4; ++j) {
            g[j] = logsigmoidf(g[j] + bias[t]) * (1.f / 16.f);
            ghi[j] = bf2f(f2bf(g[j])); glo[j] = g[j] - ghi[j];
          }
          bN[t] = mfma16(pk4(ghi), triB, F4Z);
          bN[t] = mfma16(pk4(glo), triB, bN[t]);
          float p0 = g[0], p1 = p0 + g[1], p2 = p1 + g[2], p3 = p2 + g[3];
          float off = 0.f;
          float s1 = __shfl_up(p3, 16), s2 = __shfl_up(p3, 32), s3 = __shfl_up(p3, 48);
          if (quad >= 1) off += s1;
          if (quad >= 2) off += s2;
          if (quad >= 3) off += s3;
          bC[t] = (f32x4){p0 + off, p1 + off, p2 + off, p3 + off};
        }
        bf16x8 qe, ke;
        {
          u32x4 qu = __builtin_bit_cast(u32x4, qn), ku = __builtin_bit_cast(u32x4, kn);
          u32x4 qo, ko;
#pragma unroll
          for (int w = 0; w < 4; ++w) {
            float b0 = bN[w >> 1][(w & 1) * 2], b1 = bN[w >> 1][(w & 1) * 2 + 1];
            qo[w] = pack2(bf2f(qu[w] & 0xffff) * 0.17677669529663687f * fexp(b0), bf2f(qu[w] >> 16) * 0.17677669529663687f * fexp(b1));
            ko[w] = pack2(bf2f(ku[w] & 0xffff) * fexp(-b0), bf2f(ku[w] >> 16) * fexp(-b1));
          }
          qe = __builtin_bit_cast(bf16x8, qo); ke = __builtin_bit_cast(bf16x8, ko);
        }
        f32x4 AT = mfma16(ke, qe, F4Z);
#pragma unroll
        for (int j = 0; j < 4; ++j) AT[j] = (l15 >= quad * 4 + j) ? AT[j] : 0.f;
        const u32x4 aa = __builtin_bit_cast(u32x4, pk4(AT));
        f32x4 KC[2];
        KC[0] = mfma16(kn, selE, F4Z); KC[1] = mfma16(kn, selO, F4Z);
        u32x4 kdu[2]; f32x4 cdq[2];
#pragma unroll
        for (int dt = 0; dt < 2; ++dt) {
          const float blC = __shfl(bC[dt][3], 48 + l15);
          f32x4 kd;
#pragma unroll
          for (int j = 0; j < 4; ++j) {
            kd[j] = KC[dt][j] * fexp(blC - bC[dt][j]);
            cdq[dt][j] = fexp(__shfl(bN[dt][j], quad * 16 + 15));
          }
          kdu[dt] = __builtin_bit_cast(u32x4, pk4(kd));
        }
        u32x4 vcu[4];
#pragma unroll
        for (int et = 0; et < 4; ++et) vcu[et] = __builtin_bit_cast(u32x4, pk4(VC[et]));
        const int slot = n & (SCAN_R - 1);
        ring_wait(done + slot, n - SCAN_R + 1);
        asm volatile("" ::: "memory");
        u32x4* sp = slots + slot * SCAN_SLOT_V4 * 64;
        sp[0 * 64] = __builtin_bit_cast(u32x4, qe);
        sp[1 * 64] = (u32x4){aa.x, aa.y, kdu[0].x, kdu[0].y};
        sp[2 * 64] = (u32x4){kdu[1].x, kdu[1].y, vcu[0].x, vcu[0].y};
        sp[3 * 64] = (u32x4){vcu[1].x, vcu[1].y, vcu[2].x, vcu[2].y};
        sp[4 * 64] = (u32x4){vcu[3].x, vcu[3].y, 0u, 0u};
        sp[5 * 64] = __builtin_bit_cast(u32x4, cdq[0]);
        sp[6 * 64] = __builtin_bit_cast(u32x4, cdq[1]);
        asm volatile("s_waitcnt lgkmcnt(0)" ::: "memory");
        ready[slot] = n + 1;
        asm volatile("" ::: "memory");
      }
      __syncthreads();
    }
  } else {
    f32x4 St[2][4];
#pragma unroll
    for (int a2 = 0; a2 < 2; ++a2)
#pragma unroll
      for (int b2 = 0; b2 < 4; ++b2) St[a2][b2] = F4Z;
    u32x2 rpk[4] = {(u32x2){0u, 0u}, (u32x2){0u, 0u}, (u32x2){0u, 0u}, (u32x2){0u, 0u}};
    u16* prev_ptr = OUT + (size_t)(dir ? S - 1 - l15 : l15) * 256 + quad * 4;
#pragma unroll 1
    for (int half = 0; half < 2; ++half) {
      const int nbeg = half * (N >> 1), nend = nbeg + (N >> 1);
#pragma unroll 1
      for (int n = nbeg; n < nend; ++n) {
        const int t0 = dir ? S - 16 * (n + 1) : 16 * n;
#pragma unroll
        for (int et = 0; et < 4; ++et) *(u32x2*)(prev_ptr + et * 16) = rpk[et];
        {
          const size_t row = (size_t)(dir ? t0 + 15 - l15 : t0 + l15);
          prev_ptr = (half == 0 ? OUT : SLOT) + row * 256 + quad * 4;
        }
        const int slot = n & (SCAN_R - 1);
        ring_wait(ready + slot, n + 1);
        asm volatile("" ::: "memory");
        const u32x4* sp = slots + slot * SCAN_SLOT_V4 * 64;
        const u32x4 m0 = sp[0 * 64], m1 = sp[1 * 64], m2 = sp[2 * 64], m3 = sp[3 * 64], m4 = sp[4 * 64], m5 = sp[5 * 64], m6 = sp[6 * 64];
        asm volatile("s_waitcnt lgkmcnt(0)" ::: "memory");
        done[slot] = n + 1;
        asm volatile("" ::: "memory");
        const bf16x8 qe = __builtin_bit_cast(bf16x8, m0);
        const bf16x8 atp = __builtin_bit_cast(bf16x8, (u32x4){m1.x, m1.y, 0u, 0u});
        bf16x8 kdp[2], vcp[4];
        kdp[0] = __builtin_bit_cast(bf16x8, (u32x4){m1.z, m1.w, 0u, 0u}); kdp[1] = __builtin_bit_cast(bf16x8, (u32x4){m2.x, m2.y, 0u, 0u});
        vcp[0] = __builtin_bit_cast(bf16x8, (u32x4){m2.z, m2.w, 0u, 0u}); vcp[1] = __builtin_bit_cast(bf16x8, (u32x4){m3.x, m3.y, 0u, 0u});
        vcp[2] = __builtin_bit_cast(bf16x8, (u32x4){m3.z, m3.w, 0u, 0u}); vcp[3] = __builtin_bit_cast(bf16x8, (u32x4){m4.x, m4.y, 0u, 0u});
        f32x4 cdq[2]; cdq[0] = __builtin_bit_cast(f32x4, m5); cdq[1] = __builtin_bit_cast(f32x4, m6);
        f32x4 O[4];
#pragma unroll
        for (int et = 0; et < 4; ++et) {
          O[et] = mfma16(vcp[et], atp, F4Z);
          O[et] = mfma16(pk8(St[0][et], St[1][et]), qe, O[et]);
        }
#pragma unroll
        for (int dt = 0; dt < 2; ++dt)
#pragma unroll
          for (int et = 0; et < 4; ++et) {
            f32x4 c = St[dt][et];
#pragma unroll
            for (int j = 0; j < 4; ++j) c[j] *= cdq[dt][j];
            St[dt][et] = mfma16(kdp[dt], vcp[et], c);
          }
#pragma unroll
        for (int et = 0; et < 4; ++et) rpk[et] = (u32x2){pack2(O[et][0], O[et][1]), pack2(O[et][2], O[et][3])};
      }
#pragma unroll
      for (int et = 0; et < 4; ++et) *(u32x2*)(prev_ptr + et * 16) = rpk[et];
      __syncthreads();
    }
  }
  scan_combine(OUT, SLOT, 256, (const u16*)(p.ws + OFF_LGATE) + (size_t)sbase * 256 + h * 64, S, tid);
}

DI void scan_block(const Params& p, int L, int task, u16* smem) {
  __builtin_amdgcn_s_setprio(3);
  if (task < 96) dn_task(p, L, task >> 2, task & 3, smem); else gla_task(p, L, (task - 96) >> 2, task & 3, smem);
  __builtin_amdgcn_s_setprio(0);
}

#define N_SCAN_TASKS 192
#define N_MIX_TASKS (192 + 2048 + 2048)
DI void mix_task(const Params& p, int L, int task, u16* smem) {
  if (task < N_SCAN_TASKS) {
    scan_block(p, L, task, smem);
    return;
  }
  int u = task - N_SCAN_TASKS;
  if (u < 2048) {
    int seq, h, qb;
    if (u < 1024) { seq = u >> 7; h = (u >> 5) & 3; qb = u & 31; }
    else { u -= 1024; seq = 8 + (u >> 6); h = (u >> 4) & 3; qb = u & 15; }
    int sbase = seq_base(seq), S = seq_len(seq);
    int kvh = h >> 1;
    u16* Qp = (u16*)(p.ws + OFF_C0) + (size_t)(sbase + qb * 128) * 256 + h * 64;
    const u16* Kp = (const u16*)(p.ws + OFF_AK) + (size_t)sbase * 128 + kvh * 64;
    const u16* VTp = (const u16*)(p.ws + OFF_AVT) + (size_t)sbase * 128 + (size_t)kvh * 64 * S;
    const u16* Gp = (const u16*)(p.ws + OFF_AGATE) + (size_t)(sbase + qb * 128) * 256 + h * 64;
#ifndef NO_ATT
    attn_block(Qp, Kp, 128, VTp, S, Gp, smem);
#endif
  } else {
    u -= 2048;
    int qbg = u >> 2, h = u & 3;
    int tok0 = qbg * 128;
    int seq = seq_of_token(tok0);
    u16* Qp = (u16*)(p.ws + OFF_C3) + (size_t)tok0 * 256 + h * 64;
    const u16* Kp = (const u16*)(p.ws + OFF_KM) + (size_t)seq * 256 * 256 + h * 64;
    const u16* VTp = (const u16*)(p.ws + OFF_VMT) + ((size_t)seq * 4 + h) * 64 * 256;
    const u16* Gp = (const u16*)(p.ws + OFF_MGATE) + (size_t)tok0 * 256 + h * 64;
#ifndef NO_ATT
    attn_block(Qp, Kp, 256, VTp, 256, Gp, smem);
#endif
  }
}

DI void phase_final(const Params& p, int gtid, int gthreads) {
  int wid = gtid >> 6, nw = gthreads >> 6, lane = gtid & 63;
  const float* HF = (const float*)(p.ws + OFF_HFINAL);
  const float* SUMSQ = (const float*)(p.ws + OFF_SUMSQ);
  float4 g[4];
#pragma unroll
  for (int i = 0; i < 4; ++i) g[i] = *(const float4*)(p.final_norm_g + i * 256 + lane * 4);
  for (int t0 = wid; t0 < T_TOK; t0 += 2 * nw) {
    float4 v[2][4]; float ssq[2];
#pragma unroll
    for (int u = 0; u < 2; ++u) {
      const int t = t0 + u * nw < T_TOK ? t0 + u * nw : t0;
      ssq[u] = lane < 16 ? SUMSQ[(size_t)t * 16 + lane] : 0.f;
#pragma unroll
      for (int i = 0; i < 4; ++i) v[u][i] = *(const float4*)(HF + (size_t)t * 1024 + i * 256 + lane * 4);
    }
#pragma unroll
    for (int u = 0; u < 2; ++u) {
      const int t = t0 + u * nw;
      if (t < T_TOK) {
        const float r = rsqrtf(wave_sum(ssq[u]) * (1.f / 1024.f) + EPSF);
#pragma unroll
        for (int i = 0; i < 4; ++i) {
          const float4 a = v[u][i];
          *(float4*)(p.out + (size_t)t * 1024 + i * 256 + lane * 4) = make_float4(a.x * r * g[i].x, a.y * r * g[i].y, a.z * r * g[i].z, a.w * r * g[i].w);
        }
      }
    }
  }
}

#define XB_TMO      128
#define XB_XCNT(j)  (256  + 64 * (j))
#define XB_XSUB(j)  (1280 + 64 * (j))
#define XB_XGEN(j)  (2304 + 64 * (j))
#define XB_TOP      3328
#define XB_TOPGEN   3392
#define XCD_BAR_WORDS 3456
#define XB_SPIN_CAP (1u << 18)
#define LAS __attribute__((address_space(3)))

__device__ __forceinline__ unsigned xb_ld(unsigned* p)              { return __hip_atomic_load(p, __ATOMIC_RELAXED, __HIP_MEMORY_SCOPE_AGENT); }
__device__ __forceinline__ unsigned xb_add(unsigned* p, unsigned v) { return __hip_atomic_fetch_add(p, v, __ATOMIC_RELAXED, __HIP_MEMORY_SCOPE_AGENT); }
__device__ __forceinline__ unsigned xb_xcc_id() { return (unsigned)__builtin_amdgcn_s_getreg((3 << 11) | 20) & 0xFu; }
#define XB_SPIN(cond, bar) do { unsigned _sp = 0; while (cond) { __builtin_amdgcn_s_sleep(1); \
    if ((++_sp & 255u) == 0u) { if (xb_ld(&(bar)[XB_TMO])) break; if (_sp > XB_SPIN_CAP) { atomicAdd(&(bar)[XB_TMO], 1u); break; } } } } while (0)

struct XcdBarrier {
    unsigned* bar; unsigned x;
    volatile LAS unsigned* st;
};

__device__ __forceinline__ XcdBarrier xcd_barrier_post(unsigned* bar, volatile LAS unsigned* st) {
    XcdBarrier b; b.bar = bar; b.x = xb_xcc_id(); b.st = st;
    if (threadIdx.x == 0) (void)xb_add(&bar[XB_XCNT(b.x)], 1u);
    return b;
}
__device__ __forceinline__ void xcd_barrier_complete(unsigned* bar, unsigned x, unsigned& nloc, unsigned& nx) {
    const unsigned G = gridDim.x * gridDim.y * gridDim.z;
    unsigned sum, cnt, mine, sp = 0u;
    for (;;) {
        sum = 0u; cnt = 0u; mine = 0u;
#pragma unroll
        for (unsigned j = 0; j < 16; ++j) { const unsigned c = xb_ld(&bar[XB_XCNT(j)]); sum += c; cnt += (c > 0u) ? 1u : 0u; mine = (j == x) ? c : mine; }
        if (sum == G) break;
        __builtin_amdgcn_s_sleep(1);
        if ((++sp & 255u) == 0u) { if (xb_ld(&bar[XB_TMO])) break; if (sp > XB_SPIN_CAP) { atomicAdd(&bar[XB_TMO], 1u); break; } }
    }
    nloc = mine > 0u ? mine : 1u; nx = cnt > 0u ? cnt : 1u;
}

__device__ __forceinline__ void xcd_barrier(const XcdBarrier& b) {
    asm volatile("s_waitcnt vmcnt(0)" ::: "memory");
    __syncthreads();
    if (threadIdx.x == 0) {
        unsigned* bar = b.bar;
        __builtin_amdgcn_s_waitcnt(0);
        unsigned nloc = b.st[0], nx = b.st[1];
        if (nloc == 0u) { xcd_barrier_complete(bar, b.x, nloc, nx); b.st[0] = nloc; b.st[1] = nx; }
        const unsigned old = xb_add(&bar[XB_XSUB(b.x)], 1u);
        const unsigned gen = old / nloc;
        if (old + 1u == (gen + 1u) * nloc) {
            __builtin_amdgcn_fence(__ATOMIC_RELEASE, "agent");
            asm volatile("s_waitcnt vmcnt(0)" ::: "memory");
            const unsigned og = xb_add(&bar[XB_TOP], 1u);
            const unsigned tg = og / nx;
            if (og + 1u == (tg + 1u) * nx) xb_add(&bar[XB_TOPGEN], 1u);
            else XB_SPIN(xb_ld(&bar[XB_TOPGEN]) == tg, bar);
            __builtin_amdgcn_fence(__ATOMIC_ACQUIRE, "agent");
            xb_add(&bar[XB_XGEN(b.x)], 1u);
            asm volatile("s_waitcnt vmcnt(0)" ::: "memory");
        } else {
            XB_SPIN(xb_ld(&bar[XB_XGEN(b.x)]) == gen, bar);
            __builtin_amdgcn_fence(__ATOMIC_ACQUIRE, "agent");
            asm volatile("s_waitcnt vmcnt(0)" ::: "memory");
        }
    }
    __syncthreads();
}


#define N_PHASES 18
#ifndef LB_MIN
#define LB_MIN 2
#endif
#define SMEM_BYTES (384 * LDS_STRIDE * 2 + 1024)

template <bool COOP>
__global__ void __launch_bounds__(256, LB_MIN) mega(Params p, int ph_lo, int ph_hi) {
  extern __shared__ __attribute__((aligned(16))) unsigned char smem_raw[];
  __shared__ int s_task;
  __shared__ int s_elig;
  __shared__ uint4 xb_words;
  u16* smem = (u16*)smem_raw;
  const int gthreads = gridDim.x * 256;
  XcdBarrier xb;
  if (COOP) {
    if (threadIdx.x == 0) xb_words = make_uint4(0u, 0u, 0u, 0u);
    __syncthreads();
    xb = xcd_barrier_post((unsigned*)(p.ws + OFF_XBAR), (volatile LAS unsigned*)&xb_words);
  }
  for (int ph = ph_lo; ph < ph_hi; ++ph) {
    const int gtid = blockIdx.x * 256 + otid();
    if (ph == 0) {
#ifndef NO_P0
      phase_prep(p, gtid, gthreads);
#endif
    } else if (ph == N_PHASES - 1) {
#ifndef NO_FIN
      phase_final(p, gtid, gthreads);
#endif
    } else {
      int L = (ph - 1) / 4, sub = (ph - 1) % 4;
      if (sub == 0) {
        for (int t = blockIdx.x; t < 13 * 512 + 96; t += gridDim.x) {
#ifndef NO_G1
          if (t < 13 * 512) g1_tile(p, L, t, smem);
#endif
#ifndef NO_G3
          if (t >= 13 * 512) g3_tile(p, L, t - 13 * 512, smem);
#endif
        }
      } else if (sub == 1) {
#ifndef NO_PREP
        for (int t = blockIdx.x; t < 2048; t += gridDim.x) prep_task(p, L, t, smem);
#endif
      } else if (sub == 2) {
        int* cnt_scan = (int*)(p.ws + OFF_CNT) + L;
        int* cnt_att = (int*)(p.ws + OFF_CNT) + 4 + L;
        __syncthreads();
        if (threadIdx.x == 0) {
          unsigned xcc = __builtin_amdgcn_s_getreg((3 << 11) | (0 << 6) | 20);
          unsigned hw = __builtin_amdgcn_s_getreg((15 << 11) | (0 << 6) | 4);
          unsigned cu = (hw >> 8) & 0xf, sh = (hw >> 12) & 1, se = (hw >> 13) & 7;
          unsigned cuid = (((xcc & 15) * 8 + se) * 2 + sh) * 16 + cu;
          s_elig = atomicCAS((int*)(p.ws + OFF_CUFLAG) + L * 4096 + cuid, 0, 1) == 0 ? 1 : 0;
        }
        while (true) {
          __syncthreads();
          if (threadIdx.x == 0) {
            int task = -1;
            if (s_elig) { int t = atomicAdd(cnt_scan, 1); if (t < N_SCAN_TASKS) task = t; else s_elig = 0; }
            if (task < 0) { int t = atomicAdd(cnt_att, 1); task = t < (N_MIX_TASKS - N_SCAN_TASKS) ? N_SCAN_TASKS + t : N_MIX_TASKS; }
            s_task = task;
          }
          __syncthreads();
          int task = s_task;
          if (task >= N_MIX_TASKS) break;
          mix_task(p, L, task, smem);
        }
      } else {
#ifndef NO_G2
        for (int t = blockIdx.x; t < 2048; t += gridDim.x) g2_tile(p, L, t, smem);
#endif
      }
    }
    if (COOP && ph + 1 < ph_hi) {
      if (ph == 0) cg::this_grid().sync();
      else xcd_barrier(xb);
    }
  }
}

extern "C" void kernel_launch(void* const* d_in, const int* in_sizes, int n_in, void* d_out, int out_size,
                              void* d_ws, size_t ws_size, hipStream_t stream) {
  if (ws_size < WS_NEED) { fprintf(stderr, "ws too small: %zu < %zu\n", ws_size, (size_t)WS_NEED); return; }
  Params p{};
  const float** pp = (const float**)&p;
  for (int i = 0; i < 19; ++i) pp[i] = (const float*)d_in[i];
  p.out = (float*)d_out; p.ws = (unsigned char*)d_ws;
  (void)hipMemsetAsync((unsigned char*)d_ws + OFF_CNT, 0, 256 + 4 * 4096 * 4 + 3456 * 4, stream);
  static int grid_blocks = 0;
  if (!grid_blocks) {
    int dev = 0, cus = 0, per_cu = 0;
    (void)hipGetDevice(&dev);
    (void)hipDeviceGetAttribute(&cus, hipDeviceAttributeMultiprocessorCount, dev);
    (void)hipFuncSetAttribute((const void*)mega<true>, hipFuncAttributeMaxDynamicSharedMemorySize, SMEM_BYTES);
    (void)hipOccupancyMaxActiveBlocksPerMultiprocessor(&per_cu, mega<true>, 256, SMEM_BYTES);
    if (per_cu < 1) per_cu = 1;
    if (per_cu > 2) per_cu = 2;
    grid_blocks = cus * per_cu;
  }
  int ph_lo = 0, ph_hi = N_PHASES;
  void* args[] = {&p, &ph_lo, &ph_hi};
  hipError_t e = hipLaunchCooperativeKernel((void*)mega<true>, dim3(grid_blocks), dim3(256), args, SMEM_BYTES, stream);
  if (e != hipSuccess) fprintf(stderr, "cooperative launch failed: %s (grid %d)\n", hipGetErrorString(e), grid_blocks);
}
```
